# Optimizing an MI355X kernel written in HIP

```python
import jax, jax.numpy as jnp
from jax import lax
import numpy as np

D_MODEL = 1024
BATCH = 4
SEQ = 8192
DEPTH = 1

CHUNK = 64
N_MEM = 256
ATT_HEADS = 8
HEAD_DIM = 64
D_ATT = ATT_HEADS * HEAD_DIM
D_LRU = D_MODEL - D_ATT
LRU_BLOCKS = 8
LRU_BLOCK = D_LRU // LRU_BLOCKS
CONV_W = 4
LRU_C = 8.0
LEFT_CHUNKS = 8
BAND = (LEFT_CHUNKS + 1) * CHUNK
MAX_REL = 128
X_HEADS = 4
X_HEAD_DIM = D_MODEL // X_HEADS
D_FF = -(-8 * D_MODEL // (3 * 256)) * 256
D_IN = 3 * D_ATT + 2 * D_LRU
EPS = 1e-6

kernel_name = "hymba_chunk_attn_rglru_xmem_swiglu"


def rmsnorm(x, g):
    x32 = x.astype(jnp.float32)
    y = x32 * lax.rsqrt(jnp.mean(x32 * x32, axis=-1, keepdims=True) + EPS)
    return (y * g.astype(jnp.float32)).astype(x.dtype)


def chunk_attention(q, k, v, rel_bias):
    B, S, H, Dh = q.shape
    nc = S // CHUNK
    pad = LEFT_CHUNKS * CHUNK
    kp = jnp.pad(k, ((0, 0), (pad, 0), (0, 0), (0, 0)))
    vp = jnp.pad(v, ((0, 0), (pad, 0), (0, 0), (0, 0)))
    rel = (LEFT_CHUNKS * CHUNK + np.arange(CHUNK)[:, None]) - np.arange(BAND)[None, :]
    idx = np.clip(rel, -MAX_REL, MAX_REL) + MAX_REL
    bias = rel_bias[:, idx].astype(jnp.float32)
    qc = q.reshape(B, nc, CHUNK, H, Dh).transpose(1, 0, 2, 3, 4)
    scale = HEAD_DIM ** -0.5
    key_off = jnp.arange(BAND, dtype=jnp.int32)

    def one_chunk(args):
        c, qb = args
        kb = lax.dynamic_slice_in_dim(kp, c * CHUNK, BAND, axis=1)
        vb = lax.dynamic_slice_in_dim(vp, c * CHUNK, BAND, axis=1)
        s = jnp.einsum('bqhd,bkhd->bhqk', qb, kb).astype(jnp.float32) * scale + bias
        valid = (c - LEFT_CHUNKS) * CHUNK + key_off >= 0
        s = jnp.where(valid, s, -1e30)
        p = jax.nn.softmax(s, axis=-1).astype(vb.dtype)
        return jnp.einsum('bhqk,bkhd->bqhd', p, vb)

    o = lax.map(one_chunk, (jnp.arange(nc, dtype=jnp.int32), qc))
    return o.transpose(1, 0, 2, 3, 4).reshape(B, S, H * Dh)


def causal_conv(u, w, b):
    S = u.shape[1]
    up = jnp.pad(u, ((0, 0), (CONV_W - 1, 0), (0, 0)))
    out = up[:, 0:S] * w[0]
    for j in range(1, CONV_W):
        out = out + up[:, j:j + S] * w[j]
    return out + b


def _lin_combine(left, right):
    a_l, b_l = left
    a_r, b_r = right
    return a_r * a_l, a_r * b_l + b_r


def rg_lru(u, w_rg, b_rg, w_ig, b_ig, L):
    B, S, _ = u.shape
    ub = u.reshape(B, S, LRU_BLOCKS, LRU_BLOCK)
    r = jax.nn.sigmoid(jnp.einsum('bsnc,ncd->bsnd', ub, w_rg).reshape(B, S, D_LRU) + b_rg)
    i = jax.nn.sigmoid(jnp.einsum('bsnc,ncd->bsnd', ub, w_ig).reshape(B, S, D_LRU) + b_ig)
    log_a = -LRU_C * r.astype(jnp.float32) * jax.nn.softplus(-L.astype(jnp.float32))
    a = jnp.exp(log_a)
    mult = jnp.sqrt(jnp.maximum(-jnp.expm1(2.0 * log_a), 0.0))
    b = mult * (i * u).astype(jnp.float32)
    _, h = lax.associative_scan(_lin_combine, (a, b), axis=1)
    return h.astype(u.dtype)


def setup_inputs(seed: int = 0) -> dict:
    key = jax.random.key(seed)
    ks = jax.random.split(key, 32)
    f32 = jnp.float32

    def w(k, shape, fan_in):
        return jax.random.normal(k, shape, f32) * (fan_in ** -0.5)

    def gain(k, shape):
        return 1.0 + 0.05 * jax.random.normal(k, shape, f32)

    def small(k, shape, s=0.01):
        return s * jax.random.normal(k, shape, f32)

    a0 = jax.random.uniform(ks[11], (DEPTH, D_LRU), f32, 0.9, 0.999) ** (1.0 / LRU_C)
    lru_L = jnp.log(a0) - jnp.log1p(-a0)
    return {
        "x": jax.random.normal(ks[0], (BATCH, SEQ, D_MODEL), f32),
        "mem": jax.random.normal(ks[1], (BATCH, N_MEM, D_MODEL), f32),
        "g_mix": gain(ks[2], (DEPTH, D_MODEL)),
        "w_in": w(ks[3], (DEPTH, D_MODEL, D_IN), D_MODEL),
        "rel_bias": 0.1 * jax.random.normal(ks[4], (DEPTH, ATT_HEADS, 2 * MAX_REL + 1), f32),
        "conv_w": w(ks[5], (DEPTH, CONV_W, D_LRU), CONV_W),
        "conv_b": small(ks[6], (DEPTH, D_LRU)),
        "w_rg": w(ks[7], (DEPTH, LRU_BLOCKS, LRU_BLOCK, LRU_BLOCK), LRU_BLOCK),
        "b_rg": small(ks[8], (DEPTH, D_LRU)),
        "w_ig": w(ks[9], (DEPTH, LRU_BLOCKS, LRU_BLOCK, LRU_BLOCK), LRU_BLOCK),
        "b_ig": small(ks[10], (DEPTH, D_LRU)),
        "lru_L": lru_L,
        "g_out_attn": gain(ks[12], (DEPTH, D_ATT)),
        "g_out_lru": gain(ks[13], (DEPTH, D_LRU)),
        "w_out": w(ks[14], (DEPTH, D_ATT + D_LRU, D_MODEL), D_ATT + D_LRU),
        "g_cross": gain(ks[15], (DEPTH, D_MODEL)),
        "g_mem": gain(ks[16], (DEPTH, D_MODEL)),
        "wq_c": w(ks[17], (DEPTH, D_MODEL, D_MODEL), D_MODEL),
        "wk_c": w(ks[18], (DEPTH, D_MODEL, D_MODEL), D_MODEL),
        "wv_c": w(ks[19], (DEPTH, D_MODEL, D_MODEL), D_MODEL),
        "wo_c": w(ks[20], (DEPTH, D_MODEL, D_MODEL), D_MODEL),
        "g_ffn": gain(ks[21], (DEPTH, D_MODEL)),
        "w_gate": w(ks[22], (DEPTH, D_MODEL, D_FF), D_MODEL),
        "w_up": w(ks[23], (DEPTH, D_MODEL, D_FF), D_MODEL),
        "w_down": w(ks[24], (DEPTH, D_FF, D_MODEL), D_FF),
        "g_final": gain(ks[25], (D_MODEL,)),
    }


def reference(x, mem, g_mix, w_in, rel_bias, conv_w, conv_b, w_rg, b_rg, w_ig, b_ig, lru_L,
              g_out_attn, g_out_lru, w_out, g_cross, g_mem, wq_c, wk_c, wv_c, wo_c,
              g_ffn, w_gate, w_up, w_down, g_final):
    B, S, _ = x.shape
    M = mem.shape[1]
    splits = [D_ATT, 2 * D_ATT, 3 * D_ATT, 3 * D_ATT + D_LRU]
    for l in range(DEPTH):
        h = rmsnorm(x, g_mix[l])
        proj = h @ w_in[l]
        q, k, v, xu, gu = jnp.split(proj, splits, axis=-1)
        att = chunk_attention(q.reshape(B, S, ATT_HEADS, HEAD_DIM),
                              k.reshape(B, S, ATT_HEADS, HEAD_DIM),
                              v.reshape(B, S, ATT_HEADS, HEAD_DIM), rel_bias[l])
        xu = causal_conv(xu, conv_w[l], conv_b[l])
        rec = rg_lru(xu, w_rg[l], b_rg[l], w_ig[l], b_ig[l], lru_L[l]) * jax.nn.gelu(gu)
        merged = jnp.concatenate([rmsnorm(att, g_out_attn[l]), rmsnorm(rec, g_out_lru[l])], axis=-1)
        x = x + merged @ w_out[l]

        hc = rmsnorm(x, g_cross[l])
        mn = rmsnorm(mem, g_mem[l])
        qx = (hc @ wq_c[l]).reshape(B, S, X_HEADS, X_HEAD_DIM)
        kx = (mn @ wk_c[l]).reshape(B, M, X_HEADS, X_HEAD_DIM)
        vx = (mn @ wv_c[l]).reshape(B, M, X_HEADS, X_HEAD_DIM)
        s = jnp.einsum('bshd,bmhd->bhsm', qx, kx).astype(jnp.float32) * (X_HEAD_DIM ** -0.5)
        p = jax.nn.softmax(s, axis=-1).astype(vx.dtype)
        ox = jnp.einsum('bhsm,bmhd->bshd', p, vx).reshape(B, S, D_MODEL)
        x = x + ox @ wo_c[l]

        hf = rmsnorm(x, g_ffn[l])
        x = x + (jax.nn.silu(hf @ w_gate[l]) * (hf @ w_up[l])) @ w_down[l]
    return rmsnorm(x, g_final)
```

```cpp
#include <hip/hip_runtime.h>
#include <cstdio>
#include <cstdint>
namespace pg8 {
#define PG8_LAS __attribute__((address_space(3)))
typedef unsigned short bf16_t;
typedef short bf16x8 __attribute__((ext_vector_type(8)));
typedef float f32x4 __attribute__((ext_vector_type(4)));
typedef unsigned u32x4 __attribute__((ext_vector_type(4)));
constexpr int BM = 256, BK = 64, HALF = 128, HTB = HALF * BK * 2  , STAGE_BYTES = 8 * HTB, NXCD = 8, WGM = 4;

__host__ __device__ __forceinline__ int lds_byte(int r, int c) { const int st = (r >> 4) * 2 + (c >> 5), rr = r & 15, cc = c & 31, ob = rr * 64 + cc * 2; return st * 1024 + (ob ^ (((ob >> 9) & 1) << 5)); }
__host__ __device__ __forceinline__ void stage_rc(int b, int& R, int& C) { const int st = b / 1024, sb = b % 1024, swz = sb ^ (((sb >> 9) & 1) << 5); R = (st >> 1) * 16 + swz / 64; C = (st & 1) * 32 + (swz % 64) / 2; }
__host__ __device__ __forceinline__ int perm32(int rho) { const int n = rho >> 4, i = rho & 15; return 8 * (i >> 2) + 4 * n + (i & 3); }

struct Unit { int pm, pn; };
struct Gemm { const bf16_t* A; const bf16_t* Bt; int M, N, K; };

struct StaticOrder {
    int nM, nN, nwg, G, c;
    __host__ __device__ void init(int M, int N, int G_, int c_) { nM = M / BM; nN = N / BM; nwg = nM * nN; G = G_; c = c_; }
    __host__ __device__ bool next(int i, Unit& u) const {
        const long L = (long)i * G + c; if (L >= nwg) return false;
        int wgid = (int)L; { const int q = nwg / NXCD, r = nwg % NXCD, xcd = wgid % NXCD, off = wgid / NXCD; wgid = (xcd < r ? xcd * (q + 1) : r * (q + 1) + (xcd - r) * q) + off; }
        const int nig = WGM * nN, gid = wgid / nig, fm = gid * WGM, gsz = (nM - fm) < WGM ? (nM - fm) : WGM;
        u.pm = fm + ((wgid % nig) % gsz); u.pn = (wgid % nig) / gsz; return true;
    }
    __device__ __forceinline__ void a_ready(const Unit&) const {}
    __device__ __forceinline__ void done(const Unit&) const {}
};

__device__ __forceinline__ unsigned cvt_pk_bf16(float lo, float hi) { unsigned r; asm volatile("v_cvt_pk_bf16_f32 %0, %1, %2" : "=v"(r) : "v"(lo), "v"(hi)); return r; }
typedef float f32x2 __attribute__((ext_vector_type(2)));
typedef unsigned u32x4e __attribute__((ext_vector_type(4)));
__device__ __forceinline__ float xor32e(float v) { const unsigned u = __builtin_bit_cast(unsigned, v); auto rr = __builtin_amdgcn_permlane32_swap(u, u, false, false); return __builtin_bit_cast(float, (unsigned)(rr[0] ^ rr[1] ^ u)); }
__device__ __forceinline__ float row_rs16(const float* ss, int row, int fq) {
    const f32x4 a = *(const f32x4*)(ss + (size_t)row * 16 + 4 * fq);
    float s = (a[0] + a[1]) + (a[2] + a[3]);
    s += __shfl_xor(s, 16); s += xor32e(s);
    return 1.0f / sqrtf(s * (1.0f / 1024.0f) + 1e-6f);
}
struct EpiBf {
    static constexpr bool PERM = true, AFTER_DRAIN = false;
    bf16_t* O; int ldc; const float* ss; int qcols; float qs; bool perm16; const float* rsv = nullptr; int rsmode = 0;
    __device__ __forceinline__ void operator()(const f32x4 (&acc)[2][2][4][2], const Unit& u, int wr, int wc, int fr, int fq) const {
        const int row0 = u.pm * BM + wr * 64 + fr, col0 = u.pn * BM + wc * 32 + 8 * fq;
        const float cs = (u.pn * BM < qcols) ? qs : 1.0f;
#pragma unroll
        for (int ai = 0; ai < 2; ++ai)
#pragma unroll
            for (int m = 0; m < 4; ++m) { const int row = row0 + ai * HALF + m * 16; bf16_t* rowp = O + (size_t)row * ldc + col0;
                const float sc = (ss ? row_rs16(ss, row, fq) : 1.0f) * cs * (rsmode == 1 ? rsv[row] : 1.0f);
#pragma unroll
                for (int bj = 0; bj < 2; ++bj) { f32x4 v0 = acc[ai][bj][m][0] * sc, v1 = acc[ai][bj][m][1] * sc;
                    if (rsmode == 2) { v0 = v0 * *(const f32x4*)(rsv + col0 + bj * HALF); v1 = v1 * *(const f32x4*)(rsv + col0 + bj * HALF + 4); }
                    u32x4e w; w.x = cvt_pk_bf16(v0[0], v0[1]); w.y = cvt_pk_bf16(v0[2], v0[3]); w.z = cvt_pk_bf16(v1[0], v1[1]); w.w = cvt_pk_bf16(v1[2], v1[3]);
                    if (perm16) { typedef unsigned u32x2e __attribute__((ext_vector_type(2))); bf16_t* gp = rowp + bj * HALF - 8 * (fq & 1);
                        *(u32x2e*)(gp + 4 * (fq & 1)) = (u32x2e){w.x, w.y}; *(u32x2e*)(gp + 8 + 4 * (fq & 1)) = (u32x2e){w.z, w.w}; }
                    else *(u32x4e*)(rowp + bj * HALF) = w; } }
    }
};
__device__ __forceinline__ f32x4 bf_lo4(unsigned a, unsigned b) { return (f32x4){__builtin_bit_cast(float, a << 16), __builtin_bit_cast(float, a & 0xffff0000u), __builtin_bit_cast(float, b << 16), __builtin_bit_cast(float, b & 0xffff0000u)}; }
template <bool BASE_F32> struct EpiRes {
    static constexpr bool PERM = true, AFTER_DRAIN = false;
    const float* basef; const bf16_t* xin; bf16_t* xb; float* ss;
    __device__ __forceinline__ void operator()(const f32x4 (&acc)[2][2][4][2], const Unit& u, int wr, int wc, int fr, int fq) const {
        const int row0 = u.pm * BM + wr * 64 + fr, col0 = u.pn * BM + wc * 32 + 8 * fq;
        if constexpr (BASE_F32) {
#pragma unroll
            for (int ai = 0; ai < 2; ++ai) {
                f32x4 pre[4][2][2];
#pragma unroll
                for (int m = 0; m < 4; ++m)
#pragma unroll
                    for (int bj = 0; bj < 2; ++bj) { const size_t off = (size_t)(row0 + ai * HALF + m * 16) * 1024 + col0 + bj * HALF; pre[m][bj][0] = *(const f32x4*)(basef + off); pre[m][bj][1] = *(const f32x4*)(basef + off + 4); }
                __builtin_amdgcn_sched_barrier(0);
#pragma unroll
                for (int m = 0; m < 4; ++m) { const int row = row0 + ai * HALF + m * 16; const size_t off = (size_t)row * 1024 + col0; float q = 0.f;
#pragma unroll
                    for (int bj = 0; bj < 2; ++bj) { const f32x4 v0 = acc[ai][bj][m][0] + pre[m][bj][0], v1 = acc[ai][bj][m][1] + pre[m][bj][1];
                        q += ((v0[0] * v0[0] + v0[1] * v0[1]) + (v0[2] * v0[2] + v0[3] * v0[3])) + ((v1[0] * v1[0] + v1[1] * v1[1]) + (v1[2] * v1[2] + v1[3] * v1[3]));
                        u32x4e w; w.x = cvt_pk_bf16(v0[0], v0[1]); w.y = cvt_pk_bf16(v0[2], v0[3]); w.z = cvt_pk_bf16(v1[0], v1[1]); w.w = cvt_pk_bf16(v1[2], v1[3]);
                        *(u32x4e*)(xb + off + bj * HALF) = w; }
                    q += __shfl_xor(q, 16); q += xor32e(q); if (fq == 0) ss[(size_t)row * 16 + u.pn * 4 + wc] = q; }
                __builtin_amdgcn_sched_barrier(0);
            }
        } else {
            u32x4e pre[2][4][2];
#pragma unroll
            for (int ai = 0; ai < 2; ++ai)
#pragma unroll
                for (int m = 0; m < 4; ++m)
#pragma unroll
                    for (int bj = 0; bj < 2; ++bj) pre[ai][m][bj] = *(const u32x4e*)(xin + (size_t)(row0 + ai * HALF + m * 16) * 1024 + col0 + bj * HALF);
            __builtin_amdgcn_sched_barrier(0);
#pragma unroll
            for (int ai = 0; ai < 2; ++ai)
#pragma unroll
                for (int m = 0; m < 4; ++m) { const int row = row0 + ai * HALF + m * 16; const size_t off = (size_t)row * 1024 + col0; float q = 0.f;
#pragma unroll
                    for (int bj = 0; bj < 2; ++bj) { const u32x4e pw = pre[ai][m][bj];
                        const f32x4 v0 = acc[ai][bj][m][0] + bf_lo4(pw.x, pw.y), v1 = acc[ai][bj][m][1] + bf_lo4(pw.z, pw.w);
                        q += ((v0[0] * v0[0] + v0[1] * v0[1]) + (v0[2] * v0[2] + v0[3] * v0[3])) + ((v1[0] * v1[0] + v1[1] * v1[1]) + (v1[2] * v1[2] + v1[3] * v1[3]));
                        u32x4e w; w.x = cvt_pk_bf16(v0[0], v0[1]); w.y = cvt_pk_bf16(v0[2], v0[3]); w.z = cvt_pk_bf16(v1[0], v1[1]); w.w = cvt_pk_bf16(v1[2], v1[3]);
                        *(u32x4e*)(xb + off + bj * HALF) = w; }
                    q += __shfl_xor(q, 16); q += xor32e(q); if (fq == 0) ss[(size_t)row * 16 + u.pn * 4 + wc] = q; }
        }
    }
};
struct EpiFinal {
    static constexpr bool PERM = true, AFTER_DRAIN = false;
    const bf16_t* xb; float* out; const float* g; float* ss; unsigned* cnt; int dbg;
    __device__ __forceinline__ void operator()(f32x4 (&acc)[2][2][4][2], const Unit& u, int wr, int wc, int fr, int fq) const {
        const int row0 = u.pm * BM + wr * 64 + fr, col0 = u.pn * BM + wc * 32 + 8 * fq;
        u32x4e pre[2][4][2];
#pragma unroll
        for (int ai = 0; ai < 2; ++ai)
#pragma unroll
            for (int m = 0; m < 4; ++m)
#pragma unroll
                for (int bj = 0; bj < 2; ++bj) pre[ai][m][bj] = *(const u32x4e*)(xb + (size_t)(row0 + ai * HALF + m * 16) * 1024 + col0 + bj * HALF);
        __builtin_amdgcn_sched_barrier(0);
#pragma unroll
        for (int ai = 0; ai < 2; ++ai)
#pragma unroll
            for (int m = 0; m < 4; ++m) { const int row = row0 + ai * HALF + m * 16; float q = 0.f;
#pragma unroll
                for (int bj = 0; bj < 2; ++bj) { const u32x4e w = pre[ai][m][bj];
                    const f32x4 b0 = bf_lo4(w.x, w.y), b1 = bf_lo4(w.z, w.w);
                    const f32x4 v0 = acc[ai][bj][m][0] + b0, v1 = acc[ai][bj][m][1] + b1; acc[ai][bj][m][0] = v0; acc[ai][bj][m][1] = v1;
                    q += ((v0[0] * v0[0] + v0[1] * v0[1]) + (v0[2] * v0[2] + v0[3] * v0[3])) + ((v1[0] * v1[0] + v1[1] * v1[1]) + (v1[2] * v1[2] + v1[3] * v1[3])); }
                q += __shfl_xor(q, 16); q += xor32e(q);
                if (fq == 0) __hip_atomic_store(ss + (size_t)row * 16 + u.pn * 4 + wc, q, __ATOMIC_RELAXED, __HIP_MEMORY_SCOPE_AGENT); }
        asm volatile("s_waitcnt vmcnt(0)" ::: "memory");
        unsigned* c = cnt + 64 * u.pm;
        if (!(dbg & 2)) {
        if ((fr | fq) == 0) __hip_atomic_fetch_add(c, 1u, __ATOMIC_RELAXED, __HIP_MEMORY_SCOPE_AGENT);
        { unsigned sp = 0; while (__hip_atomic_load(c, __ATOMIC_RELAXED, __HIP_MEMORY_SCOPE_AGENT) < 32u) { __builtin_amdgcn_s_sleep(16); if (++sp > (1u << 20)) break; } }
        }
        const int gc = u.pn * BM + wc * 32 + 8 * fq;
        f32x4 gv[2][2];
#pragma unroll
        for (int bj = 0; bj < 2; ++bj) { gv[bj][0] = *(const f32x4*)(g + gc + bj * HALF); gv[bj][1] = *(const f32x4*)(g + gc + bj * HALF + 4); }
#pragma unroll
        for (int ai = 0; ai < 2; ++ai)
#pragma unroll
            for (int m = 0; m < 4; ++m) { const int row = row0 + ai * HALF + m * 16; const size_t off = (size_t)row * 1024 + col0; float s = 0.f;
#pragma unroll
                for (int k = 0; k < 2; ++k) { const unsigned long long w = __hip_atomic_load((const unsigned long long*)(ss + (size_t)row * 16 + 4 * fq) + k, __ATOMIC_RELAXED, __HIP_MEMORY_SCOPE_AGENT);
                    s += __uint_as_float((unsigned)w) + __uint_as_float((unsigned)(w >> 32)); }
                s += __shfl_xor(s, 16); s += xor32e(s);
                const float rs = 1.0f / sqrtf(s * (1.0f / 1024.0f) + 1e-6f);
                if (!(dbg & 4))
#pragma unroll
                for (int bj = 0; bj < 2; ++bj) { *(f32x4*)(out + off + bj * HALF) = acc[ai][bj][m][0] * rs * gv[bj][0]; *(f32x4*)(out + off + bj * HALF + 4) = acc[ai][bj][m][1] * rs * gv[bj][1]; } }
    }
};
struct EpiSwiGLU {
    static constexpr bool PERM = true, AFTER_DRAIN = false;
    bf16_t* O; int ldc; const float* ss;
    __device__ __forceinline__ void operator()(const f32x4 (&acc)[2][2][4][2], const Unit& u, int wr, int wc, int fr, int fq) const {
        const int row0 = u.pm * BM + wr * 64 + fr, col0 = u.pn * HALF + wc * 32 + 8 * fq;
#pragma unroll
        for (int ai = 0; ai < 2; ++ai)
#pragma unroll
            for (int m = 0; m < 4; ++m) { const int row = row0 + ai * HALF + m * 16; const float sc = row_rs16(ss, row, fq);
                float a[8];
#pragma unroll
                for (int n = 0; n < 2; ++n)
#pragma unroll
                    for (int e = 0; e < 4; ++e) { const float g = acc[ai][0][m][n][e] * sc, up = acc[ai][1][m][n][e] * sc;
                        const float sg = g * __builtin_amdgcn_rcpf(1.0f + __builtin_amdgcn_exp2f(-1.4426950408889634f * g)); a[4 * n + e] = sg * up; }
                u32x4e w; w.x = cvt_pk_bf16(a[0], a[1]); w.y = cvt_pk_bf16(a[2], a[3]); w.z = cvt_pk_bf16(a[4], a[5]); w.w = cvt_pk_bf16(a[6], a[7]);
                *(u32x4e*)(O + (size_t)row * ldc + col0) = w; }
    }
};
template <class Epi, class Sched, bool ALIGN_EPI = false, bool SP2 = false>
__device__ __forceinline__ void gemm_phase(PG8_LAS unsigned char* lds, const Gemm g, const Sched& S, const Epi& E) {
    const int tid = threadIdx.x, wid = __builtin_amdgcn_readfirstlane(tid >> 6), lane = tid & 63, wr = wid >> 2, wc = wid & 3, fr = lane & 15, fq = lane >> 4;
    const int K = g.K, nt = K / BK;
    unsigned voffA[2], voffB[2];
#pragma unroll
    for (int i = 0; i < 2; ++i) { int R, C; stage_rc(tid * 16 + i * 8192, R, C); const int Rb = Epi::PERM ? ((R & ~31) + perm32(R & 31)) : R;
        voffA[i] = (unsigned)(R * K + C) * 2u; voffB[i] = (unsigned)(Rb * K + C) * 2u; }
    const size_t kstep = (size_t)(BK * 2);
    const size_t hstep = (size_t)HALF * K * 2;
    const size_t tstep = 2 * hstep;
    const unsigned ldsw = (unsigned)wid * 1024u;
    const int aoff = lds_byte(wr * 64 + fr, fq * 8), boff = lds_byte(wc * 32 + fr, fq * 8);
#define PG8_SA(b, h) (((b) * 2 + (h)) * HTB)
#define PG8_SB(b, h) ((4 + (b) * 2 + (h)) * HTB)
#define PG8_STAGE(bufoff, gbase, voff) do { _Pragma("unroll") for (int _i = 0; _i < 2; ++_i) \
        __builtin_amdgcn_global_load_lds((const unsigned*)((const char*)(gbase) + (voff)[_i]), (PG8_LAS unsigned*)(lds + (bufoff) + ldsw + _i * 8192), 16, 0, 0); } while (0)
#define PG8_LDA(dst, b, h) do { _Pragma("unroll") for (int m = 0; m < 4; ++m) _Pragma("unroll") for (int k = 0; k < 2; ++k) dst[m][k] = *(const PG8_LAS bf16x8*)(lds + PG8_SA(b, h) + aoff + m * 2048 + k * 1024); } while (0)
#define PG8_LDB(dst, b, h) do { _Pragma("unroll") for (int n = 0; n < 2; ++n) _Pragma("unroll") for (int k = 0; k < 2; ++k) dst[n][k] = *(const PG8_LAS bf16x8*)(lds + PG8_SB(b, h) + boff + n * 2048 + k * 1024); } while (0)
#define PG8_MMA(ai, bj, At, Bt) do { __builtin_amdgcn_s_setprio(1); _Pragma("unroll") for (int m = 0; m < 4; ++m) _Pragma("unroll") for (int n = 0; n < 2; ++n) _Pragma("unroll") for (int k = 0; k < 2; ++k) \
        acc[ai][bj][m][n] = __builtin_amdgcn_mfma_f32_16x16x32_bf16(Bt[n][k], At[m][k], acc[ai][bj][m][n], 0, 0, 0); __builtin_amdgcn_s_setprio(0); } while (0)
#define PG8_WAIT_V(n) asm volatile("s_waitcnt vmcnt(" #n ")" ::: "memory")
#define PG8_WAIT_L(n) asm volatile("s_waitcnt lgkmcnt(" #n ")" ::: "memory")
#define PG8_BAR __builtin_amdgcn_s_barrier()
#define PG8_SCHED __builtin_amdgcn_sched_barrier(0)
    Unit cur, nxt; int ui = 0;
    if (!S.next(0, cur)) return;
    f32x4 acc[2][2][4][2];
#pragma unroll
    for (int a = 0; a < 2; ++a)
#pragma unroll
        for (int b = 0; b < 2; ++b)
#pragma unroll
            for (int m = 0; m < 4; ++m)
#pragma unroll
                for (int n = 0; n < 2; ++n) acc[a][b][m][n] = (f32x4){0.f, 0.f, 0.f, 0.f};
    bf16x8 At[4][2], B0[2][2], B1[2][2];
    const char* cA = (const char*)g.A + (size_t)cur.pm * tstep; const char* cB = (const char*)g.Bt + (size_t)cur.pn * tstep;
    S.a_ready(cur);
    if constexpr (SP2) {
        PG8_STAGE(PG8_SB(0, 0), cB, voffB); PG8_STAGE(PG8_SB(0, 1), cB + hstep, voffB); PG8_STAGE(PG8_SA(0, 0), cA, voffA); PG8_STAGE(PG8_SA(0, 1), cA + hstep, voffA);
        if (wr == 1) PG8_BAR;
        PG8_WAIT_V(2); PG8_BAR;
        PG8_STAGE(PG8_SB(1, 0), cB + kstep, voffB); PG8_STAGE(PG8_SA(1, 0), cA + kstep, voffA); PG8_STAGE(PG8_SB(1, 1), cB + hstep + kstep, voffB);
        PG8_WAIT_V(6); PG8_BAR;
    } else {
        PG8_STAGE(PG8_SB(0, 0), cB, voffB); PG8_STAGE(PG8_SA(0, 0), cA, voffA); PG8_STAGE(PG8_SB(0, 1), cB + hstep, voffB); PG8_STAGE(PG8_SA(0, 1), cA + hstep, voffA);
        if (wr == 1) PG8_BAR;
        PG8_WAIT_V(4); PG8_BAR;
        PG8_STAGE(PG8_SB(1, 0), cB + kstep, voffB); PG8_STAGE(PG8_SA(1, 0), cA + kstep, voffA); PG8_STAGE(PG8_SB(1, 1), cB + hstep + kstep, voffB);
        PG8_WAIT_V(6); PG8_BAR;
    }
    for (;;) {
        const bool has_next = S.next(ui + 1, nxt);
        const char* nA = has_next ? (const char*)g.A + (size_t)nxt.pm * tstep : cA; const char* nB = has_next ? (const char*)g.Bt + (size_t)nxt.pn * tstep : cB;
        for (int t = 0; t < nt; t += 2) {
            const bool last = (t == nt - 2);
            const char* a1 = cA + (size_t)(t + 1) * kstep;
            const char* a2 = last ? nA : cA + (size_t)(t + 2) * kstep; const char* b2 = last ? nB : cB + (size_t)(t + 2) * kstep;
            const char* a3 = a2 + kstep; const char* b3 = b2 + kstep;
            if (last && has_next) S.a_ready(nxt);
            if constexpr (SP2) {
            PG8_LDB(B0, 0, 0); PG8_LDB(B1, 0, 1); PG8_SCHED; PG8_LDA(At, 0, 0); PG8_STAGE(PG8_SA(1, 1), a1 + hstep, voffA);
            PG8_WAIT_V(8); PG8_WAIT_L(0); PG8_BAR; PG8_MMA(0, 0, At, B0); PG8_MMA(0, 1, At, B1); PG8_BAR; PG8_SCHED;
            PG8_LDA(At, 0, 1); PG8_STAGE(PG8_SB(0, 0), b2, voffB); PG8_STAGE(PG8_SB(0, 1), b2 + hstep, voffB); PG8_STAGE(PG8_SA(0, 0), a2, voffA);
            PG8_WAIT_V(8); PG8_WAIT_L(0); PG8_BAR; PG8_MMA(1, 0, At, B0); PG8_MMA(1, 1, At, B1); PG8_BAR; PG8_SCHED;
            PG8_LDB(B0, 1, 0); PG8_LDB(B1, 1, 1); PG8_SCHED; PG8_LDA(At, 1, 0); PG8_STAGE(PG8_SA(0, 1), a2 + hstep, voffA);
            PG8_WAIT_V(8); PG8_WAIT_L(0); PG8_BAR; PG8_MMA(0, 0, At, B0); PG8_MMA(0, 1, At, B1); PG8_BAR; PG8_SCHED;
            PG8_LDA(At, 1, 1); PG8_STAGE(PG8_SB(1, 0), b3, voffB); PG8_STAGE(PG8_SB(1, 1), b3 + hstep, voffB); PG8_STAGE(PG8_SA(1, 0), a3, voffA);
            PG8_WAIT_V(8); PG8_WAIT_L(0); PG8_BAR; PG8_MMA(1, 0, At, B0); PG8_MMA(1, 1, At, B1); PG8_BAR; PG8_SCHED;
            } else {
            PG8_LDB(B0, 0, 0); PG8_SCHED; PG8_LDA(At, 0, 0); PG8_STAGE(PG8_SA(1, 1), a1 + hstep, voffA);
            PG8_WAIT_L(8); PG8_BAR; PG8_WAIT_L(0); PG8_MMA(0, 0, At, B0); PG8_BAR; PG8_SCHED;
            PG8_LDB(B1, 0, 1); PG8_STAGE(PG8_SB(0, 0), b2, voffB);
            PG8_BAR; PG8_WAIT_L(0); PG8_MMA(0, 1, At, B1); PG8_BAR;
            PG8_LDA(At, 0, 1); PG8_STAGE(PG8_SA(0, 0), a2, voffA);
            PG8_BAR; PG8_WAIT_L(0); PG8_MMA(1, 0, At, B0); PG8_BAR; PG8_SCHED;
            PG8_STAGE(PG8_SB(0, 1), b2 + hstep, voffB);
            PG8_WAIT_V(6); PG8_BAR; PG8_MMA(1, 1, At, B1); PG8_BAR;
            PG8_LDB(B0, 1, 0); PG8_SCHED; PG8_LDA(At, 1, 0); PG8_STAGE(PG8_SA(0, 1), a2 + hstep, voffA);
            PG8_WAIT_L(8); PG8_BAR; PG8_WAIT_L(0); PG8_MMA(0, 0, At, B0); PG8_BAR; PG8_SCHED;
            PG8_LDB(B1, 1, 1); PG8_STAGE(PG8_SB(1, 0), b3, voffB);
            PG8_BAR; PG8_WAIT_L(0); PG8_MMA(0, 1, At, B1); PG8_BAR;
            PG8_LDA(At, 1, 1); PG8_STAGE(PG8_SA(1, 0), a3, voffA);
            PG8_BAR; PG8_WAIT_L(0); PG8_MMA(1, 0, At, B0); PG8_BAR; PG8_SCHED;
            PG8_STAGE(PG8_SB(1, 1), b3 + hstep, voffB);
            PG8_WAIT_V(6); PG8_BAR; PG8_MMA(1, 1, At, B1); PG8_BAR;
            }
        }
        if constexpr (ALIGN_EPI) { if (wr == 0) PG8_BAR; }
        if constexpr (!Epi::AFTER_DRAIN) { E(acc, cur, wr, wc, fr, fq); S.done(cur); }
        if (!has_next) break;
#pragma unroll
        for (int a = 0; a < 2; ++a)
#pragma unroll
            for (int b = 0; b < 2; ++b)
#pragma unroll
                for (int m = 0; m < 4; ++m)
#pragma unroll
                    for (int n = 0; n < 2; ++n) acc[a][b][m][n] = (f32x4){0.f, 0.f, 0.f, 0.f};
        cur = nxt; cA = nA; cB = nB; ++ui;
        if constexpr (ALIGN_EPI) { if (wr == 1) PG8_BAR; }
    }
    PG8_WAIT_V(0);
    if constexpr (!ALIGN_EPI) { if (wr == 0) PG8_BAR; }
    PG8_BAR;
    if constexpr (Epi::AFTER_DRAIN) { E.fused(acc, cur, wr, wc, fr, fq, lds, wid, lane); S.done(cur); }
#undef PG8_SA
#undef PG8_SB
#undef PG8_STAGE
#undef PG8_LDA
#undef PG8_LDB
#undef PG8_MMA
#undef PG8_WAIT_V
#undef PG8_WAIT_L
#undef PG8_BAR
#undef PG8_SCHED
}
}

constexpr int NB = 4, SEQ = 8192, DM = 1024, T = NB * SEQ;
constexpr int NCH = SEQ / 64;
constexpr int NMEM = 256, DFF = 2816, DLRU = 512;
constexpr int PAW = 2048;
constexpr float EPS = 1e-6f, LOG2E = 1.4426950408889634f;

constexpr size_t MiB = 1u << 20;
constexpr size_t WS_WA = 2 * MiB, WS_WV = 6 * MiB, WS_WOUT = 7 * MiB, WS_WQ = 9 * MiB, WS_WK = 11 * MiB, WS_WVC = 13 * MiB, WS_WO = 15 * MiB,
                 WS_WGU = 17 * MiB, WS_WDN = 28 * MiB, WS_WRG = 34 * MiB, WS_WIG = 34 * MiB + 65536;
constexpr size_t WS_MN = 36 * MiB, WS_KX = 38 * MiB, WS_VXT = 40 * MiB, WS_SS1 = 42 * MiB, WS_SS2 = 44 * MiB, WS_LP = 46 * MiB, WS_LH = 47 * MiB;
constexpr size_t WS_PA = 48 * MiB, WS_VT = 176 * MiB, WS_XN = 208 * MiB, WS_MERGED = 272 * MiB, WS_XB = 336 * MiB, WS_HLOC = 400 * MiB, WS_END = 464 * MiB;
constexpr size_t WS_RS0 = 35 * MiB;
constexpr size_t WS_XB2 = WS_HLOC;
constexpr size_t WS_ATT = WS_XB, WS_ASS = WS_SS2;
constexpr size_t WS_ACUM = WS_XN;
constexpr size_t WS_QX = WS_XN, WS_OX = WS_MERGED, WS_ACT = WS_PA;
static_assert(WS_ACT + (size_t)T * DFF * 2 <= WS_MERGED, "ACT overlay");

constexpr int LDS_BYTES = 147456, LDS_MISC_OFF = 143360;
#define GAS __attribute__((address_space(1)))
#define LAS __attribute__((address_space(3)))
typedef unsigned short bf16;
typedef unsigned v4u __attribute__((ext_vector_type(4)));
typedef unsigned v2u __attribute__((ext_vector_type(2)));
typedef float f32x4 __attribute__((ext_vector_type(4)));
typedef float f32x16 __attribute__((ext_vector_type(16)));
typedef short bf16x8 __attribute__((ext_vector_type(8)));
typedef short s16x4 __attribute__((ext_vector_type(4)));
typedef float f32x2_t __attribute__((ext_vector_type(2)));
typedef __bf16 bf16x2_t __attribute__((ext_vector_type(2)));
__device__ __forceinline__ unsigned pk2(float lo, float hi) { f32x2_t v = {lo, hi}; bf16x2_t b = __builtin_convertvector(v, bf16x2_t); return __builtin_bit_cast(unsigned, b); }
__device__ __forceinline__ float bf2f(unsigned short u) { return __builtin_bit_cast(float, (unsigned)u << 16); }
__device__ __forceinline__ int crow(int r, int hi) { return (r & 3) + 8 * (r >> 2) + 4 * hi; }
__device__ __forceinline__ bf16x8 pack8(const float* p) { v4u w; w.x = pk2(p[0], p[1]); w.y = pk2(p[2], p[3]); w.z = pk2(p[4], p[5]); w.w = pk2(p[6], p[7]); return __builtin_bit_cast(bf16x8, w); }
__device__ __forceinline__ float xor32_get(float v) { const unsigned u = __builtin_bit_cast(unsigned, v); auto rr = __builtin_amdgcn_permlane32_swap(u, u, false, false); return __builtin_bit_cast(float, (unsigned)(rr[0] ^ rr[1] ^ u)); }
__device__ __forceinline__ float wave_sum(float v) {
#pragma unroll
    for (int o = 1; o < 64; o <<= 1) v += __shfl_xor(v, o);
    return v;
}
#define MFMA32(a, b, c) __builtin_amdgcn_mfma_f32_32x32x16_bf16((a), (b), (c), 0, 0, 0)

#define RLX_AGENT __ATOMIC_RELAXED, __HIP_MEMORY_SCOPE_AGENT
#define XB_TMO      128
#define XB_XCNT(j)  (256  + 64 * (j))
#define XB_XSUB(j)  (1280 + 64 * (j))
#define XB_XGEN(j)  (2304 + 64 * (j))
#define XB_TOP      3328
#define XB_TOPGEN   3392
#define XCD_BAR_WORDS 3456
#define XB_SPIN_CAP (1u << 18)

__device__ __forceinline__ unsigned xb_ld(unsigned* p)              { return __hip_atomic_load(p, __ATOMIC_RELAXED, __HIP_MEMORY_SCOPE_AGENT); }
__device__ __forceinline__ unsigned xb_add(unsigned* p, unsigned v) { return __hip_atomic_fetch_add(p, v, __ATOMIC_RELAXED, __HIP_MEMORY_SCOPE_AGENT); }
__device__ __forceinline__ unsigned xb_xcc_id() { return (unsigned)__builtin_amdgcn_s_getreg((3 << 11) | 20) & 0xFu; }
#define XB_SPIN(cond, bar) do { unsigned _sp = 0; while (cond) { __builtin_amdgcn_s_sleep(1); \
    if ((++_sp & 255u) == 0u) { if (xb_ld(&(bar)[XB_TMO])) break; if (_sp > XB_SPIN_CAP) { atomicAdd(&(bar)[XB_TMO], 1u); break; } } } } while (0)

struct XcdBarrier {
    unsigned* bar; unsigned x;
    volatile LAS unsigned* st;
};

__device__ __forceinline__ XcdBarrier xcd_barrier_post(unsigned* bar, volatile LAS unsigned* st) {
    XcdBarrier b; b.bar = bar; b.x = xb_xcc_id(); b.st = st;
    if (threadIdx.x == 0) (void)xb_add(&bar[XB_XCNT(b.x)], 1u);
    return b;
}
__device__ __forceinline__ void xcd_barrier_complete(unsigned* bar, unsigned x, unsigned& nloc, unsigned& nx) {
    const unsigned G = gridDim.x * gridDim.y * gridDim.z;
    unsigned sum, cnt, mine, sp = 0u;
    for (;;) {
        sum = 0u; cnt = 0u; mine = 0u;
#pragma unroll
        for (unsigned j = 0; j < 16; ++j) { const unsigned c = xb_ld(&bar[XB_XCNT(j)]); sum += c; cnt += (c > 0u) ? 1u : 0u; mine = (j == x) ? c : mine; }
        if (sum == G) break;
        __builtin_amdgcn_s_sleep(1);
        if ((++sp & 255u) == 0u) { if (xb_ld(&bar[XB_TMO])) break; if (sp > XB_SPIN_CAP) { atomicAdd(&bar[XB_TMO], 1u); break; } }
    }
    nloc = mine > 0u ? mine : 1u; nx = cnt > 0u ? cnt : 1u;
}

__device__ __forceinline__ void xcd_barrier(const XcdBarrier& b) {
    asm volatile("s_waitcnt vmcnt(0)" ::: "memory");
    __syncthreads();
    if (threadIdx.x == 0) {
        unsigned* bar = b.bar;
        __builtin_amdgcn_s_waitcnt(0);
        unsigned nloc = b.st[0], nx = b.st[1];
        if (nloc == 0u) { xcd_barrier_complete(bar, b.x, nloc, nx); b.st[0] = nloc; b.st[1] = nx; }
        const unsigned old = xb_add(&bar[XB_XSUB(b.x)], 1u);
        const unsigned gen = old / nloc;
        if (old + 1u == (gen + 1u) * nloc) {
            __builtin_amdgcn_fence(__ATOMIC_RELEASE, "agent");
            asm volatile("s_waitcnt vmcnt(0)" ::: "memory");
            const unsigned og = xb_add(&bar[XB_TOP], 1u);
            const unsigned tg = og / nx;
            if (og + 1u == (tg + 1u) * nx) xb_add(&bar[XB_TOPGEN], 1u);
            else XB_SPIN(xb_ld(&bar[XB_TOPGEN]) == tg, bar);
            __builtin_amdgcn_fence(__ATOMIC_ACQUIRE, "agent");
            xb_add(&bar[XB_XGEN(b.x)], 1u);
            asm volatile("s_waitcnt vmcnt(0)" ::: "memory");
        } else {
            XB_SPIN(xb_ld(&bar[XB_XGEN(b.x)]) == gen, bar);
            __builtin_amdgcn_fence(__ATOMIC_ACQUIRE, "agent");
            asm volatile("s_waitcnt vmcnt(0)" ::: "memory");
        }
    }
    __syncthreads();
}

struct Frame {
    LAS unsigned char* lds;
    int tid, lane, wave, G, bid;
    float* out; unsigned char* ws;
};
__device__ __forceinline__ const float* inp(int i) {
    const __attribute__((address_space(4))) char* k = (const __attribute__((address_space(4))) char*)__builtin_amdgcn_kernarg_segment_ptr();
    asm volatile("" : "+s"(k));
    return *(const float* const __attribute__((address_space(4)))*)(k + 8 * i);
}
enum { I_X = 0, I_MEM, I_GMIX, I_WIN, I_RELB, I_CONVW, I_CONVB, I_WRG, I_BRG, I_WIG, I_BIG, I_LRUL, I_GOA, I_GOL, I_WOUT, I_GCROSS, I_GMEM, I_WQC, I_WKC, I_WVC, I_WOC,
       I_GFFN, I_WGATE, I_WUP, I_WDOWN, I_GFINAL };

struct OneUnit {
    int pm, pn;
    __device__ __forceinline__ bool next(int i, pg8::Unit& u) const { if (i != 0) return false; u.pm = pm; u.pn = pn; return true; }
    __device__ __forceinline__ void a_ready(const pg8::Unit&) const {}
    __device__ __forceinline__ void done(const pg8::Unit&) const {}
};
constexpr int NMEMCU = 32;
__device__ __forceinline__ void p0_tr(const float* W, int ldw, int k0, int n0, bf16* dst, int ldd, const float* gk, LAS float* scr, int lane) {
    const float* wp = W + (size_t)k0 * ldw + n0 + lane;
    float v[64];
#pragma unroll
    for (int kk = 0; kk < 64; ++kk) v[kk] = wp[(size_t)kk * ldw];
    if (gk) {
#pragma unroll
        for (int kk = 0; kk < 64; ++kk) v[kk] *= gk[k0 + kk]; }
#pragma unroll
    for (int kk = 0; kk < 64; ++kk) scr[kk * 65 + lane] = v[kk];
    asm volatile("s_waitcnt lgkmcnt(0)" ::: "memory");
    const int c = lane & 7;
#pragma unroll
    for (int j = 0; j < 8; ++j) { const int n = (lane >> 3) + 8 * j; const LAS float* s = scr + (8 * c) * 65 + n;
        v4u o; o.x = pk2(s[0 * 65], s[1 * 65]); o.y = pk2(s[2 * 65], s[3 * 65]); o.z = pk2(s[4 * 65], s[5 * 65]); o.w = pk2(s[6 * 65], s[7 * 65]);
        *(v4u*)(dst + (size_t)n * ldd + k0 + 8 * c) = o; }
    asm volatile("s_waitcnt lgkmcnt(0)" ::: "memory");
}
__device__ __forceinline__ void rms_row_bf16(const float* xrow, const float* g, bf16* orow, int lane) {
    const f32x4* xr = (const f32x4*)xrow + lane; const f32x4* gr = (const f32x4*)g + lane;
    f32x4 v[4]; float s = 0.f;
#pragma unroll
    for (int j = 0; j < 4; ++j) { v[j] = xr[64 * j]; s += (v[j].x * v[j].x + v[j].y * v[j].y) + (v[j].z * v[j].z + v[j].w * v[j].w); }
    const float rs = 1.f / sqrtf(wave_sum(s) * (1.f / DM) + EPS);
    v2u* o8 = (v2u*)orow + lane;
#pragma unroll
    for (int j = 0; j < 4; ++j) { const f32x4 gg = gr[64 * j]; v2u w; w.x = pk2(v[j].x * rs * gg.x, v[j].y * rs * gg.y); w.y = pk2(v[j].z * rs * gg.z, v[j].w * rs * gg.w); o8[64 * j] = w; }
}
__device__ __forceinline__ void p0_prologue(Frame& F) {
    LAS float* scr = (LAS float*)(F.lds + F.wave * 16640);
    const int lane = F.lane;
    unsigned char* ws = F.ws;
    const bool memcu = F.G == 256 && F.bid >= 256 - NMEMCU;
    if (memcu) {
        const int mw = (F.bid - (256 - NMEMCU)) * 8 + F.wave;
        for (int q = mw; q < 512; q += NMEMCU * 8) { const int which = q >> 8, r = q & 255, kb = r / 16, nb = r % 16;
            p0_tr(which ? inp(I_WVC) : inp(I_WKC), DM, 64 * kb, 64 * nb, (bf16*)(ws + (which ? WS_WVC : WS_WK)) + (size_t)(64 * nb) * DM, DM, nullptr, scr, lane); }
        for (int m = mw; m < NB * NMEM; m += NMEMCU * 8) rms_row_bf16(inp(I_MEM) + (size_t)m * DM, inp(I_GMEM), (bf16*)(ws + WS_MN) + (size_t)m * DM, lane);
        asm volatile("s_waitcnt vmcnt(0)" ::: "memory"); __syncthreads();
        if (F.tid == 0) { unsigned* c = (unsigned*)(ws + 57344);
            __builtin_amdgcn_fence(__ATOMIC_RELEASE, "agent"); asm volatile("s_waitcnt vmcnt(0)" ::: "memory");
            __hip_atomic_fetch_add(c, 1u, __ATOMIC_RELAXED, __HIP_MEMORY_SCOPE_AGENT);
            unsigned sp = 0; while (__hip_atomic_load(c, __ATOMIC_RELAXED, __HIP_MEMORY_SCOPE_AGENT) < (unsigned)NMEMCU) { __builtin_amdgcn_s_sleep(2); if (++sp > (1u << 22)) break; }
            __builtin_amdgcn_fence(__ATOMIC_ACQUIRE, "agent"); asm volatile("s_waitcnt vmcnt(0)" ::: "memory"); }
        __syncthreads();
        const int j = F.bid - (256 - NMEMCU);
        if (j < 16) { pg8::Gemm g{(const pg8::bf16_t*)(ws + WS_MN), (const pg8::bf16_t*)(ws + WS_WK), NB * NMEM, DM, DM}; OneUnit S{j >> 2, j & 3};
            pg8::EpiBf E{(pg8::bf16_t*)(ws + WS_KX), DM, nullptr, 0, 1.0f, false}; pg8::gemm_phase<pg8::EpiBf, OneUnit, true, true>(F.lds, g, S, E); }
        else { pg8::Gemm g{(const pg8::bf16_t*)(ws + WS_WVC), (const pg8::bf16_t*)(ws + WS_MN), DM, NB * NMEM, DM}; OneUnit S{(j - 16) >> 2, (j - 16) & 3};
            pg8::EpiBf E{(pg8::bf16_t*)(ws + WS_VXT), NB * NMEM, nullptr, 0, 1.0f, true}; pg8::gemm_phase<pg8::EpiBf, OneUnit, true, true>(F.lds, g, S, E); }
    }
    const int NNORM = memcu || F.G != 256 ? (F.G == 256 ? (256 - NMEMCU) * 8 : F.G * 8) : (256 - NMEMCU) * 8;
    const int NSH = F.G == 256 ? 4 * NNORM + NMEMCU * 8 : NNORM;
    const int nsh = F.G == 256 ? (memcu ? 1 : 4) : 1;
    constexpr int I_IN = 16 * 40, I_SQ = 16 * 16, I_GU = 16 * 44, I_DN = 44 * 16, I_LR = 8;
    constexpr int NITEMS = I_IN + 3 * I_SQ + 2 * I_GU + I_DN + 2 * I_LR;
    for (int sh = 0; sh < nsh; ++sh) {
      const int q0 = F.G != 256 ? F.bid * 8 + F.wave : memcu ? 4 * NNORM + (F.bid - (256 - NMEMCU)) * 8 + F.wave : sh * NNORM + F.bid * 8 + F.wave;
      for (int it = q0; it < NITEMS; it += NSH) {
        int r = it;
        if (r < I_IN) { const int kb = r / 40, nb = r % 40, n0 = 64 * nb, seg = n0 >> 9, within = n0 & 511;
            bf16* dst = (seg == 2) ? (bf16*)(ws + WS_WV) + (size_t)within * DM : (bf16*)(ws + WS_WA) + (size_t)((seg < 2 ? seg : seg - 1) * 512 + within) * DM;
            p0_tr(inp(I_WIN), 2560, 64 * kb, n0, dst, DM, inp(I_GMIX), scr, lane); continue; } r -= I_IN;
        if (r < 3 * I_SQ) { const int which = r / I_SQ, q = r % I_SQ, kb = q / 16, nb = q % 16;
            const float* W = which == 0 ? inp(I_WOUT) : which == 1 ? inp(I_WQC) : inp(I_WOC);
            const size_t off = which == 0 ? WS_WOUT : which == 1 ? WS_WQ : WS_WO;
            p0_tr(W, DM, 64 * kb, 64 * nb, (bf16*)(ws + off) + (size_t)(64 * nb) * DM, DM, which == 1 ? inp(I_GCROSS) : nullptr, scr, lane); continue; } r -= 3 * I_SQ;
        if (r < 2 * I_GU) { const int which = r / I_GU, q = r % I_GU, kb = q / 44, nb = q % 44, n0 = 64 * nb;
            const int drow = 256 * (n0 >> 7) + 128 * which + (n0 & 127);
            p0_tr(which ? inp(I_WUP) : inp(I_WGATE), DFF, 64 * kb, n0, (bf16*)(ws + WS_WGU) + (size_t)drow * DM, DM, inp(I_GFFN), scr, lane); continue; } r -= 2 * I_GU;
        if (r < I_DN) { const int kb = r / 16, nb = r % 16;
            p0_tr(inp(I_WDOWN), DM, 64 * kb, 64 * nb, (bf16*)(ws + WS_WDN) + (size_t)(64 * nb) * DFF, DFF, nullptr, scr, lane); continue; } r -= I_DN;
        { const int which = r / I_LR, blk = r % I_LR;
            p0_tr((which ? inp(I_WIG) : inp(I_WRG)) + blk * 4096, 64, 0, 0, (bf16*)(ws + (which ? WS_WIG : WS_WRG)) + blk * 4096, 64, nullptr, scr, lane); }
      }
      {
        const float* X = inp(I_X); bf16* XN = (bf16*)(ws + WS_XN); float* RS0 = (float*)(ws + WS_RS0);
        for (int m0 = q0 * 4; m0 < T; m0 += NSH * 4) {
            f32x4 v[4][4];
#pragma unroll
            for (int r = 0; r < 4; ++r)
#pragma unroll
                for (int j = 0; j < 4; ++j) v[r][j] = ((const f32x4*)(X + (size_t)(m0 + r) * DM) + lane)[64 * j];
#pragma unroll
            for (int r = 0; r < 4; ++r) { float sq = 0.f;
#pragma unroll
                for (int j = 0; j < 4; ++j) sq += (v[r][j].x * v[r][j].x + v[r][j].y * v[r][j].y) + (v[r][j].z * v[r][j].z + v[r][j].w * v[r][j].w);
                const float rs = 1.f / sqrtf(wave_sum(sq) * (1.f / DM) + EPS);
                v2u* o8 = (v2u*)(XN + (size_t)(m0 + r) * DM) + lane;
#pragma unroll
                for (int j = 0; j < 4; ++j) { v2u wv; wv.x = pk2(v[r][j].x, v[r][j].y); wv.y = pk2(v[r][j].z, v[r][j].w); o8[64 * j] = wv; }
                if (lane == 0) RS0[m0 + r] = rs; }
        }
    }
    }
}

constexpr int ATT_BT_OFF = 65536;
__device__ __forceinline__ void attn_phase(Frame& F) {
    if (F.G != 256) return;
    const int lane = F.lane, w = F.wave, tid = F.tid, q32 = lane & 31, hi = lane >> 5;
    const bf16* PA = (const bf16*)(F.ws + WS_PA); const bf16* VT = (const bf16*)(F.ws + WS_VT);
    LAS float* btw = (LAS float*)(F.lds + ATT_BT_OFF);
    const int h = (F.bid >> 5) & 7, cb = F.bid & 31;
    const int c0 = 4 * cb, cq = c0 + (w >> 1), qoff = 32 * (w & 1) + q32;
    if (tid < 257) { const float* rb = inp(I_RELB) + h * 257; btw[tid] = (rb[tid] - rb[256]) * LOG2E; }
    const int kc_lo = c0 >= 8 ? c0 - 8 : 0, nstep = (c0 + 4 - kc_lo) >> 1;
    const int prow = 8 * w + (lane >> 3), plc = (lane & 7) ^ ((prow >> 1) & 7);
    const bf16* ksrc = PA + (size_t)prow * PAW + 512 + h * 64 + 8 * plc;
    const bf16* vsrc = VT + (size_t)(h * 64 + prow) * T + 8 * plc;
#define ATT_DMA(b_, kc_, slot_) do { const size_t tk_ = (size_t)(b_) * SEQ + (size_t)(kc_) * 64; \
        __builtin_amdgcn_global_load_lds((const unsigned*)(ksrc + tk_ * PAW), (LAS unsigned*)(F.lds + (slot_) * 16384 + w * 1024), 16, 0, 0); \
        __builtin_amdgcn_global_load_lds((const unsigned*)(vsrc + tk_), (LAS unsigned*)(F.lds + (slot_) * 16384 + 8192 + w * 1024), 16, 0, 0); } while (0)
#define ATT_LDQ(Q, b_) do { const bf16* qp_ = PA + ((size_t)(b_) * SEQ + (size_t)cq * 64 + qoff) * PAW + h * 64 + 8 * hi; \
        _Pragma("unroll") for (int ks = 0; ks < 4; ++ks) Q[ks] = *(const bf16x8*)(qp_ + 16 * ks); } while (0)
    bf16x8 qf[4], qn[4];
    ATT_LDQ(qf, 0);
    ATT_DMA(0, kc_lo, 0); ATT_DMA(0, kc_lo + 1, 1);
    const int sw = (q32 >> 1) & 7;
    int g = 0;
#pragma unroll 1
    for (int b = 0; b < NB; ++b) {
        f32x16 oA[2], oB[2];
#pragma unroll
        for (int dt = 0; dt < 2; ++dt)
#pragma unroll
            for (int r = 0; r < 16; ++r) { oA[dt][r] = 0.f; oB[dt][r] = 0.f; }
        float mref = 0.f; f32x2_t lsum = {0.f, 0.f}; bool first = true;
        f32x16 negm;
#pragma unroll
        for (int r = 0; r < 16; ++r) negm[r] = 0.f;
#pragma unroll 1
        for (int j = 0; j < nstep; ++j, ++g) {
            const int kc0 = kc_lo + 2 * j;
            if (b > 0 && j == 0) asm volatile("s_waitcnt vmcnt(9) lgkmcnt(0)" ::: "memory");
            else asm volatile("s_waitcnt vmcnt(0) lgkmcnt(0)" ::: "memory");
            __builtin_amdgcn_s_barrier();
            asm volatile("" ::: "memory");
            {
                const int sl = ((g + 1) & 1) * 2;
                if (j + 1 < nstep) { ATT_DMA(b, kc0 + 2, sl); ATT_DMA(b, kc0 + 3, sl + 1); }
                else if (b + 1 < NB) { ATT_DMA(b + 1, kc_lo, sl); ATT_DMA(b + 1, kc_lo + 1, sl + 1); ATT_LDQ(qn, b + 1); }
            }
            const int d0 = cq - kc0, d1 = d0 - 1;
            const bool a0 = d0 >= 0 && d0 <= 8, a1 = d1 >= 0 && d1 <= 8;
            if (a0 || a1) {
                const LAS unsigned char* t0 = F.lds + ((g & 1) * 2) * 16384; const LAS unsigned char* t1 = t0 + 16384;
                f32x16 s00 = negm, s01 = negm, s10 = negm, s11 = negm;
                if (!a0) {
#pragma unroll
                    for (int r = 0; r < 16; ++r) { s00[r] = -1e30f; s01[r] = -1e30f; } }
                if (!a1) {
#pragma unroll
                    for (int r = 0; r < 16; ++r) { s10[r] = -1e30f; s11[r] = -1e30f; } }
                if (a0 && d0 <= 2) {
                    const int relb = d0 * 64 + qoff - 4 * hi;
#pragma unroll
                    for (int r = 0; r < 16; ++r) { const int kk = (r & 3) + 8 * (r >> 2); int e0 = relb - kk, e1 = relb - 32 - kk; e0 = e0 > 128 ? 128 : e0; e1 = e1 > 128 ? 128 : e1;
                        s00[r] += btw[e0 + 128]; s01[r] += btw[e1 + 128]; } }
                if (a1 && d1 <= 2) {
                    const int relb = d1 * 64 + qoff - 4 * hi;
#pragma unroll
                    for (int r = 0; r < 16; ++r) { const int kk = (r & 3) + 8 * (r >> 2); int e0 = relb - kk, e1 = relb - 32 - kk; e0 = e0 > 128 ? 128 : e0; e1 = e1 > 128 ? 128 : e1;
                        s10[r] += btw[e0 + 128]; s11[r] += btw[e1 + 128]; } }
#pragma unroll
                for (int ks = 0; ks < 4; ++ks) { const int co = ((2 * ks + hi) ^ sw) << 4;
                    const bf16x8 k00 = *(const LAS bf16x8*)(t0 + q32 * 128 + co), k01 = *(const LAS bf16x8*)(t0 + (q32 + 32) * 128 + co);
                    const bf16x8 k10 = *(const LAS bf16x8*)(t1 + q32 * 128 + co), k11 = *(const LAS bf16x8*)(t1 + (q32 + 32) * 128 + co);
                    s00 = MFMA32(k00, qf[ks], s00); s01 = MFMA32(k01, qf[ks], s01); s10 = MFMA32(k10, qf[ks], s10); s11 = MFMA32(k11, qf[ks], s11); }
                float tm0 = fmaxf(s00[0], s01[0]), tm1 = fmaxf(s10[0], s11[0]);
#pragma unroll
                for (int r = 1; r < 16; ++r) { tm0 = fmaxf(fmaxf(tm0, s00[r]), s01[r]); tm1 = fmaxf(fmaxf(tm1, s10[r]), s11[r]); }
                float tmax = fmaxf(tm0, tm1);
                tmax = fmaxf(tmax, xor32_get(tmax));
                if (first || __any(tmax > 16.0f)) {
                    const float delta = first ? tmax : fmaxf(tmax, 0.f);
                    if (!first) { const float f = __builtin_amdgcn_exp2f(-delta); lsum *= f;
#pragma unroll
                        for (int dt = 0; dt < 2; ++dt)
#pragma unroll
                            for (int r = 0; r < 16; ++r) { oA[dt][r] *= f; oB[dt][r] *= f; } }
                    mref += delta; first = false;
#pragma unroll
                    for (int r = 0; r < 16; ++r) { s00[r] -= delta; s01[r] -= delta; s10[r] -= delta; s11[r] -= delta; negm[r] = -mref; }
                }
                float sv[64];
#pragma unroll
                for (int r = 0; r < 16; ++r) { sv[r] = __builtin_amdgcn_exp2f(s00[r]); sv[16 + r] = __builtin_amdgcn_exp2f(s01[r]); sv[32 + r] = __builtin_amdgcn_exp2f(s10[r]); sv[48 + r] = __builtin_amdgcn_exp2f(s11[r]); }
#pragma unroll
                for (int r = 0; r < 64; r += 2) lsum += (f32x2_t){sv[r], sv[r + 1]};
                bf16x8 pf[8];
#pragma unroll
                for (int k8 = 0; k8 < 8; ++k8) pf[k8] = pack8(sv + 8 * k8);
#pragma unroll
                for (int dt = 0; dt < 2; ++dt)
#pragma unroll
                    for (int k4 = 0; k4 < 4; ++k4) { const int vo = 8192 + (32 * dt + q32) * 128 + (((2 * k4 + hi) ^ sw) << 4);
                        const bf16x8 v0 = *(const LAS bf16x8*)(t0 + vo), v1 = *(const LAS bf16x8*)(t1 + vo);
                        oA[dt] = MFMA32(v0, pf[k4], oA[dt]); oB[dt] = MFMA32(v1, pf[4 + k4], oB[dt]); }
            }
        }
        const float lrun = lsum.x + lsum.y;
        const float lt = lrun + xor32_get(lrun), inv = 1.0f / lt; float q = 0.f;
        const size_t qrow = (size_t)b * SEQ + (size_t)cq * 64 + qoff;
        bf16* orow = (bf16*)(F.ws + WS_ATT) + qrow * 512 + h * 64;
#pragma unroll
        for (int dt = 0; dt < 2; ++dt)
#pragma unroll
            for (int jj = 0; jj < 4; ++jj) { const float v0 = (oA[dt][4 * jj] + oB[dt][4 * jj]) * inv, v1 = (oA[dt][4 * jj + 1] + oB[dt][4 * jj + 1]) * inv, v2 = (oA[dt][4 * jj + 2] + oB[dt][4 * jj + 2]) * inv, v3 = (oA[dt][4 * jj + 3] + oB[dt][4 * jj + 3]) * inv;
                q += (v0 * v0 + v1 * v1) + (v2 * v2 + v3 * v3);
                v2u wv; wv.x = pk2(v0, v1); wv.y = pk2(v2, v3); *(v2u*)(orow + 32 * dt + 8 * jj + 4 * hi) = wv; }
        q += xor32_get(q);
        if (hi == 0) ((float*)(F.ws + WS_ASS))[qrow * 8 + h] = q;
#pragma unroll
        for (int ks = 0; ks < 4; ++ks) qf[ks] = qn[ks];
    }
#undef ATT_DMA
#undef ATT_LDQ
    asm volatile("s_waitcnt vmcnt(0) lgkmcnt(0)" ::: "memory");
    __builtin_amdgcn_s_barrier();
    asm volatile("" ::: "memory");
}

__device__ __forceinline__ void lru1_item(Frame& F, int b, int c) {
    const int lane = F.lane, w = F.wave, q32 = lane & 31, hi = lane >> 5;
    LAS float* U = (LAS float*)(F.lds + w * 17408);
    bf16x8 wrf[2][4], wif[2][4]; float brg2[2], big2[2], sp82[2];
    { const bf16* WRG0 = (const bf16*)(F.ws + WS_WRG) + w * 4096; const bf16* WIG0 = (const bf16*)(F.ws + WS_WIG) + w * 4096;
#pragma unroll
      for (int dt = 0; dt < 2; ++dt) { const int dl = 32 * dt + q32, ch = w * 64 + dl;
#pragma unroll
          for (int ks = 0; ks < 4; ++ks) { wrf[dt][ks] = *(const bf16x8*)(WRG0 + dl * 64 + 16 * ks + 8 * hi); wif[dt][ks] = *(const bf16x8*)(WIG0 + dl * 64 + 16 * ks + 8 * hi); }
          brg2[dt] = inp(I_BRG)[ch]; big2[dt] = inp(I_BIG)[ch]; sp82[dt] = inp(I_LRUL)[ch]; } }
    const bf16* PA = (const bf16*)(F.ws + WS_PA);
    const size_t rowbase = (size_t)b * SEQ + (size_t)c * 64;
    {
        const int ch = w * 64 + lane; const float* cw = inp(I_CONVW);
        const float w0 = cw[ch], w1 = cw[512 + ch], w2 = cw[1024 + ch], w3 = cw[1536 + ch], cb = inp(I_CONVB)[ch];
        const bf16* xp = PA + 1024 + ch;
        float x0 = 0.f, x1 = 0.f, x2 = 0.f;
        if (c > 0) { x0 = bf2f(xp[(rowbase - 3) * PAW]); x1 = bf2f(xp[(rowbase - 2) * PAW]); x2 = bf2f(xp[(rowbase - 1) * PAW]); }
#pragma unroll 16
        for (int t = 0; t < 64; ++t) { const float x3 = bf2f(xp[(rowbase + t) * PAW]); U[t * 68 + lane] = ((w0 * x0 + w1 * x1) + (w2 * x2 + w3 * x3)) + cb; x0 = x1; x1 = x2; x2 = x3; }
    }
    asm volatile("s_waitcnt lgkmcnt(0)" ::: "memory");
    bf16x8 uf[2][4];
#pragma unroll
    for (int tt = 0; tt < 2; ++tt)
#pragma unroll
        for (int ks = 0; ks < 4; ++ks) { const LAS f32x4* p = (const LAS f32x4*)(U + (32 * tt + q32) * 68 + 16 * ks + 8 * hi); const f32x4 a = p[0], bq = p[1];
            float tmp[8] = {a[0], a[1], a[2], a[3], bq[0], bq[1], bq[2], bq[3]}; uf[tt][ks] = pack8(tmp); }
    unsigned* HA = (unsigned*)(F.ws + WS_HLOC); float* LP = (float*)(F.ws + WS_LP); float* LH = (float*)(F.ws + WS_LH);
#pragma unroll
    for (int dt = 0; dt < 2; ++dt) {
        const int dl = 32 * dt + q32, ch = w * 64 + dl;
        const float brg = brg2[dt], big = big2[dt];
        const float sp8 = -8.0f * LOG2E * log1pf(expf(-sp82[dt]));
        float av[2][16], hv[2][16];
#pragma unroll
        for (int tt = 0; tt < 2; ++tt) {
            f32x16 R, I;
#pragma unroll
            for (int r = 0; r < 16; ++r) { R[r] = 0.f; I[r] = 0.f; }
#pragma unroll
            for (int ks = 0; ks < 4; ++ks) { R = MFMA32(uf[tt][ks], wrf[dt][ks], R); I = MFMA32(uf[tt][ks], wif[dt][ks], I); }
#pragma unroll
            for (int r = 0; r < 16; ++r) {
                const float rg = __builtin_amdgcn_rcpf(1.0f + __builtin_amdgcn_exp2f(-LOG2E * (R[r] + brg))), ig = __builtin_amdgcn_rcpf(1.0f + __builtin_amdgcn_exp2f(-LOG2E * (I[r] + big)));
                const float a = __builtin_amdgcn_exp2f(sp8 * rg), mult = __builtin_amdgcn_sqrtf(fmaxf(1.0f - a * a, 0.0f));
                const float uval = U[(32 * tt + crow(r, hi)) * 68 + dl];
                av[tt][r] = a; hv[tt][r] = mult * ig * uval;
            }
#pragma unroll
            for (int j = 0; j < 4; ++j)
#pragma unroll
                for (int e = 1; e < 4; ++e) { hv[tt][4 * j + e] = av[tt][4 * j + e] * hv[tt][4 * j + e - 1] + hv[tt][4 * j + e]; av[tt][4 * j + e] = av[tt][4 * j + e] * av[tt][4 * j + e - 1]; }
        }
        float cA = 1.0f, cH = 0.0f;
#pragma unroll
        for (int k = 0; k < 8; ++k) {
            const int tt = k >> 2, j = k & 3; const float Ag = av[tt][4 * j + 3], Hg = hv[tt][4 * j + 3];
            const float nA = Ag * cA, nH = Ag * cH + Hg;
            const float oA = xor32_get(nA), oH = xor32_get(nH);
            const float eA = hi == 0 ? nA : oA, eH = hi == 0 ? nH : oH;
            const float fA = hi == 0 ? cA : eA, fH = hi == 0 ? cH : eH;
            const float n2A = Ag * eA, n2H = Ag * eH + Hg;
            const float o2A = xor32_get(n2A), o2H = xor32_get(n2H);
            cA = hi == 1 ? n2A : o2A; cH = hi == 1 ? n2H : o2H;
#pragma unroll
            for (int e = 0; e < 4; ++e) { hv[tt][4 * j + e] = av[tt][4 * j + e] * fH + hv[tt][4 * j + e]; av[tt][4 * j + e] = av[tt][4 * j + e] * fA; }
        }
#pragma unroll
        for (int tt = 0; tt < 2; ++tt)
#pragma unroll
            for (int r = 0; r < 16; ++r) U[(32 * tt + crow(r, hi)) * 68 + dl] = __builtin_bit_cast(float, pk2(hv[tt][r], av[tt][r]));
        if (hi == 1) { const size_t off = (size_t)(b * NCH + c) * DLRU + ch; LP[off] = av[1][15]; LH[off] = hv[1][15]; }
    }
    asm volatile("s_waitcnt lgkmcnt(0)" ::: "memory");
#pragma unroll 4
    for (int j = 0; j < 16; ++j) { const int t = 4 * j + (lane >> 4), c4 = lane & 15;
        const f32x4 v = *(const LAS f32x4*)(U + t * 68 + 4 * c4);
        *(f32x4*)(HA + (rowbase + t) * DLRU + w * 64 + 4 * c4) = v; }
    asm volatile("s_waitcnt lgkmcnt(0)" ::: "memory");
}

__device__ __forceinline__ float gelu_tanh(float x) {
    const float y = fminf(fmaxf(0.7978845608028654f * (x + 0.044715f * x * x * x), -15.0f), 15.0f);
    const float e = __builtin_amdgcn_exp2f(-2.0f * LOG2E * y);
    const float th = (1.0f - e) * __builtin_amdgcn_rcpf(1.0f + e);
    return 0.5f * x * (1.0f + th);
}
__device__ __forceinline__ void lru3_item(Frame& F, int b, int c, bool have, float (&cH)[8]) {
    const int lane = F.lane, w = F.wave;
    const unsigned* HA = (const unsigned*)(F.ws + WS_HLOC);
    const float* LP = (const float*)(F.ws + WS_LP); const float* LH = (const float*)(F.ws + WS_LH);
    const bf16* PA = (const bf16*)(F.ws + WS_PA); bf16* MG = (bf16*)(F.ws + WS_MERGED);
    const bf16* ATT = (const bf16*)(F.ws + WS_ATT); const float* ASS = (const float*)(F.ws + WS_ASS);
    LAS f32x4* SA = (LAS f32x4*)F.lds; LAS f32x4* SH = (LAS f32x4*)(F.lds + 16384);
    if (have) { const size_t off = (size_t)(b * NCH + c - 1) * DLRU + 8 * lane;
        const f32x4 p0 = *(const f32x4*)(LP + off), p1 = *(const f32x4*)(LP + off + 4), h0 = *(const f32x4*)(LH + off), h1 = *(const f32x4*)(LH + off + 4);
#pragma unroll
        for (int e = 0; e < 4; ++e) { cH[e] = p0[e] * cH[e] + h0[e]; cH[4 + e] = p1[e] * cH[4 + e] + h1[e]; } }
    else {
        const int per = (c + 7) >> 3, j0 = w * per, j1 = (j0 + per) < c ? (j0 + per) : c;
        float A[8], H[8];
#pragma unroll
        for (int e = 0; e < 8; ++e) { A[e] = 1.f; H[e] = 0.f; }
#pragma unroll 4
        for (int j = j0; j < j1; ++j) { const size_t off = (size_t)(b * NCH + j) * DLRU + 8 * lane;
            const f32x4 p0 = *(const f32x4*)(LP + off), p1 = *(const f32x4*)(LP + off + 4), h0 = *(const f32x4*)(LH + off), h1 = *(const f32x4*)(LH + off + 4);
#pragma unroll
            for (int e = 0; e < 4; ++e) { H[e] = p0[e] * H[e] + h0[e]; A[e] *= p0[e]; H[4 + e] = p1[e] * H[4 + e] + h1[e]; A[4 + e] *= p1[e]; } }
        SA[w * 128 + 2 * lane] = (f32x4){A[0], A[1], A[2], A[3]}; SA[w * 128 + 2 * lane + 1] = (f32x4){A[4], A[5], A[6], A[7]};
        SH[w * 128 + 2 * lane] = (f32x4){H[0], H[1], H[2], H[3]}; SH[w * 128 + 2 * lane + 1] = (f32x4){H[4], H[5], H[6], H[7]};
        __syncthreads();
#pragma unroll
        for (int e = 0; e < 8; ++e) cH[e] = 0.f;
#pragma unroll
        for (int sg = 0; sg < 8; ++sg) { const f32x4 a0 = SA[sg * 128 + 2 * lane], a1 = SA[sg * 128 + 2 * lane + 1], h0 = SH[sg * 128 + 2 * lane], h1 = SH[sg * 128 + 2 * lane + 1];
#pragma unroll
            for (int e = 0; e < 4; ++e) { cH[e] = a0[e] * cH[e] + h0[e]; cH[4 + e] = a1[e] * cH[4 + e] + h1[e]; } }
    }
    const f32x4 g0 = *(const f32x4*)(inp(I_GOL) + 8 * lane), g1 = *(const f32x4*)(inp(I_GOL) + 8 * lane + 4);
    const f32x4 ga0 = *(const f32x4*)(inp(I_GOA) + 8 * lane), ga1 = *(const f32x4*)(inp(I_GOA) + 8 * lane + 4);
#pragma unroll 1
    for (int tb = 0; tb < 8; tb += 4) {
        v4u hl[4], ac[4]; f32x4 as_[4][2]; v4u gu[4], av[4];
#pragma unroll
        for (int r = 0; r < 4; ++r) { const size_t row = (size_t)b * SEQ + (size_t)c * 64 + 8 * w + tb + r, off = row * DLRU + 8 * lane;
            hl[r] = *(const v4u*)(HA + off); ac[r] = *(const v4u*)(HA + off + 4);
            gu[r] = *(const v4u*)(PA + row * PAW + 1536 + 8 * lane); av[r] = *(const v4u*)(ATT + row * 512 + 8 * lane);
            as_[r][0] = *(const f32x4*)(ASS + row * 8); as_[r][1] = *(const f32x4*)(ASS + row * 8 + 4); }
#pragma unroll
        for (int r = 0; r < 4; ++r) { const size_t row = (size_t)b * SEQ + (size_t)c * 64 + 8 * w + tb + r;
            float rec[8]; float q = 0.f;
#pragma unroll
            for (int e = 0; e < 8; ++e) { const unsigned pw = e < 4 ? hl[r][e & 3] : ac[r][e & 3];
                const float hv = __builtin_bit_cast(float, pw << 16), a = __builtin_bit_cast(float, pw & 0xffff0000u);
                const unsigned wv = gu[r][e >> 1]; const float gv = (e & 1) ? __builtin_bit_cast(float, wv & 0xffff0000u) : __builtin_bit_cast(float, wv << 16);
                rec[e] = (hv + a * cH[e]) * gelu_tanh(gv); q += rec[e] * rec[e]; }
            const float rs = 1.0f / sqrtf(wave_sum(q) * (1.0f / 512.0f) + EPS);
            v4u o; o.x = pk2(rec[0] * rs * g0[0], rec[1] * rs * g0[1]); o.y = pk2(rec[2] * rs * g0[2], rec[3] * rs * g0[3]);
            o.z = pk2(rec[4] * rs * g1[0], rec[5] * rs * g1[1]); o.w = pk2(rec[6] * rs * g1[2], rec[7] * rs * g1[3]);
            *(v4u*)(MG + row * DM + 512 + 8 * lane) = o;
            const f32x4 s0 = as_[r][0], s1 = as_[r][1];
            const float rsa = 1.0f / sqrtf((((s0[0] + s0[1]) + (s0[2] + s0[3])) + ((s1[0] + s1[1]) + (s1[2] + s1[3]))) * (1.0f / 512.0f) + EPS);
            float a[8];
#pragma unroll
            for (int e = 0; e < 8; ++e) { const unsigned wv = av[r][e >> 1]; a[e] = ((e & 1) ? __builtin_bit_cast(float, wv & 0xffff0000u) : __builtin_bit_cast(float, wv << 16)) * rsa; }
            v4u oa; oa.x = pk2(a[0] * ga0[0], a[1] * ga0[1]); oa.y = pk2(a[2] * ga0[2], a[3] * ga0[3]); oa.z = pk2(a[4] * ga1[0], a[5] * ga1[1]); oa.w = pk2(a[6] * ga1[2], a[7] * ga1[3]);
            *(v4u*)(MG + row * DM + 8 * lane) = oa;
        }
    }
    __syncthreads();
}

__device__ __forceinline__ void xattn_phase(Frame& F, const pg8::StaticOrder& S) {
    const int lane = F.lane, w = F.wave, q32 = lane & 31, hi = lane >> 5;
    LAS unsigned char* L = F.lds;
    const bf16* QX = (const bf16*)(F.ws + WS_QX); const bf16* KX = (const bf16*)(F.ws + WS_KX); const bf16* VXT = (const bf16*)(F.ws + WS_VXT); bf16* OX = (bf16*)(F.ws + WS_OX);
#define XID(u_) (((((u_).pm >> 5) * 4 + (u_).pn) << 5) | ((u_).pm & 31))
#define XA_DMA_K(it_, qd_, slot_) do { const int bh_ = (it_) >> 5, b_ = bh_ >> 2, h_ = bh_ & 3; \
        _Pragma("unroll") for (int j = 0; j < 4; ++j) { const int row_ = 8 * (4 * w + j) + (lane >> 3), lc_ = (lane & 7) ^ ((row_ >> 1) & 7); \
            __builtin_amdgcn_global_load_lds((const unsigned*)(KX + (size_t)(b_ * NMEM + row_) * DM + h_ * 256 + 64 * (qd_) + 8 * lc_), (LAS unsigned*)(L + (slot_) * 32768 + (4 * w + j) * 1024), 16, 0, 0); } } while (0)
#define XA_DMA_V(it_, qd_, slot_) do { const int bh_ = (it_) >> 5, b_ = bh_ >> 2, h_ = bh_ & 3; \
        _Pragma("unroll") for (int j = 0; j < 4; ++j) { const int row_ = 2 * (4 * w + j) + (lane >> 5), lc_ = (lane & 31) ^ (row_ & 31); \
            __builtin_amdgcn_global_load_lds((const unsigned*)(VXT + (size_t)(h_ * 256 + 64 * (qd_) + row_) * (NB * NMEM) + b_ * NMEM + 8 * lc_), (LAS unsigned*)(L + (slot_) * 32768 + (4 * w + j) * 1024), 16, 0, 0); } } while (0)
#define XA_DMA_Q(it_, qd_) do { const int tb_ = (it_) & 31, bh_ = (it_) >> 5; \
        _Pragma("unroll") for (int j = 0; j < 4; ++j) { const int row_ = 8 * j + (lane >> 3), lc_ = (lane & 7) ^ ((row_ >> 1) & 7); \
            __builtin_amdgcn_global_load_lds((const unsigned*)(QX + ((size_t)(bh_ >> 2) * SEQ + (size_t)tb_ * 256 + 32 * w + row_) * DM + (bh_ & 3) * 256 + 64 * (qd_) + 8 * lc_), (LAS unsigned*)(L + 98304 + w * 4096 + j * 1024), 16, 0, 16  ); } } while (0)
#define XA_SYNC(N) do { asm volatile("s_waitcnt vmcnt(" #N ") lgkmcnt(0)" ::: "memory"); __builtin_amdgcn_s_barrier(); asm volatile("" ::: "memory"); } while (0)
    pg8::Unit ucur; if (!S.next(0, ucur)) return;
    int it = XID(ucur);
    int s0 = 0, s1 = 1, s2 = 2;
#define XA_ROT() do { const int t_ = s0; s0 = s1; s1 = s2; s2 = t_; } while (0)
    XA_DMA_Q(it, 0); XA_DMA_K(it, 0, s0); XA_DMA_K(it, 1, s1);
    const float C = 0.0625f * LOG2E;
    const int swk = (q32 >> 1) & 7;
#pragma unroll 1
    for (int kq = 0;; ++kq) {
        const int tb = it & 31, bh = it >> 5, b = bh >> 2, h = bh & 3;
        const size_t row0 = (size_t)b * SEQ + (size_t)tb * 256 + 32 * w;
        pg8::Unit unx; const bool more = S.next(kq + 1, unx); const int itn = more ? XID(unx) : it;
        bf16x8 pf[16]; float inv;
        {
            f32x16 s[8];
#pragma unroll
            for (int mt = 0; mt < 8; ++mt)
#pragma unroll
                for (int r = 0; r < 16; ++r) s[mt][r] = 0.f;
#define XK_STEP(WAITN, QNEXT, DMA2) do { XA_SYNC(WAITN); bf16x8 q4[4]; \
                _Pragma("unroll") for (int k = 0; k < 4; ++k) q4[k] = *(const LAS bf16x8*)(L + 98304 + w * 4096 + q32 * 128 + (((2 * k + hi) ^ swk) << 4)); \
                asm volatile("s_waitcnt lgkmcnt(0)" ::: "memory"); \
                QNEXT; DMA2; \
                _Pragma("unroll") for (int k = 0; k < 4; ++k) { const int co = ((2 * k + hi) ^ swk) << 4; bf16x8 kf[8]; \
                    _Pragma("unroll") for (int mt = 0; mt < 8; ++mt) kf[mt] = *(const LAS bf16x8*)(L + s0 * 32768 + (32 * mt + q32) * 128 + co); \
                    _Pragma("unroll") for (int mt = 0; mt < 8; ++mt) s[mt] = MFMA32(kf[mt], q4[k], s[mt]); \
                      \
                    __builtin_amdgcn_sched_group_barrier(0x100, 4, 0); \
                    _Pragma("unroll") for (int i = 0; i < 4; ++i) { __builtin_amdgcn_sched_group_barrier(0x008, 1, 0); __builtin_amdgcn_sched_group_barrier(0x100, 1, 0); } \
                    __builtin_amdgcn_sched_group_barrier(0x008, 4, 0); \
                    __builtin_amdgcn_sched_barrier(0); } \
                XA_ROT(); } while (0)
            if (kq == 0) { XK_STEP(4, XA_DMA_Q(it, 1), XA_DMA_K(it, 2, s2)); } else { XK_STEP(12, XA_DMA_Q(it, 1), XA_DMA_K(it, 2, s2)); }
            XK_STEP(4, XA_DMA_Q(it, 2), XA_DMA_K(it, 3, s2));
            XK_STEP(4, XA_DMA_Q(it, 3), XA_DMA_V(it, 0, s2));
            XK_STEP(4, (void)0, XA_DMA_V(it, 1, s2));
#undef XK_STEP
            float mx = -INFINITY;
#pragma unroll
            for (int mt = 0; mt < 8; ++mt)
#pragma unroll
                for (int r = 0; r < 16; ++r) mx = fmaxf(mx, s[mt][r]);
            mx = fmaxf(mx, xor32_get(mx));
            const float mc = mx * C; float sum = 0.f;
#pragma unroll
            for (int mt = 0; mt < 8; ++mt) { float p[16];
#pragma unroll
                for (int r = 0; r < 16; ++r) { p[r] = __builtin_amdgcn_exp2f(s[mt][r] * C - mc); sum += p[r]; }
                pf[2 * mt] = pack8(p); pf[2 * mt + 1] = pack8(p + 8); }
            sum += xor32_get(sum);
            inv = 1.0f / sum;
        }
        bf16* orow0 = OX + (row0 + q32) * DM + h * 256;
#define XV_STEP(WAITN, VD, QNEXT, DMA2) do { XA_SYNC(WAITN); QNEXT; DMA2; \
            _Pragma("unroll 1") for (int dq = 0; dq < 2; ++dq) { \
                f32x16 o0; _Pragma("unroll") for (int r = 0; r < 16; ++r) o0[r] = 0.f; \
                const LAS unsigned char* vp = L + s0 * 32768 + (32 * dq + q32) * 512; \
                _Pragma("unroll") for (int kk = 0; kk < 16; ++kk) { const bf16x8 vf = *(const LAS bf16x8*)(vp + (((2 * kk + hi) ^ q32) << 4)); o0 = MFMA32(vf, pf[kk], o0); } \
                __builtin_amdgcn_sched_group_barrier(0x100, 6, 0); \
                _Pragma("unroll") for (int i = 0; i < 10; ++i) { __builtin_amdgcn_sched_group_barrier(0x008, 1, 0); __builtin_amdgcn_sched_group_barrier(0x100, 1, 0); } \
                __builtin_amdgcn_sched_group_barrier(0x008, 6, 0); \
                __builtin_amdgcn_sched_barrier(0); \
                _Pragma("unroll") for (int j = 0; j < 4; ++j) { v2u wa; wa.x = pk2(o0[4 * j] * inv, o0[4 * j + 1] * inv); wa.y = pk2(o0[4 * j + 2] * inv, o0[4 * j + 3] * inv); \
                    *(v2u*)(orow0 + 64 * (VD) + 32 * dq + 8 * j + 4 * hi) = wa; } } \
            XA_ROT(); } while (0)
        XV_STEP(4,  0, (void)0, XA_DMA_V(it, 2, s2));
        XV_STEP(12, 1, (void)0, XA_DMA_V(it, 3, s2));
        XV_STEP(12, 2, (void)0, XA_DMA_K(itn, 0, s2));
        XV_STEP(12, 3, XA_DMA_Q(itn, 0), XA_DMA_K(itn, 1, s2));
#undef XV_STEP
        if (!more) break;
        it = itn;
    }
    XA_SYNC(0);
#undef XA_DMA_K
#undef XA_DMA_V
#undef XA_DMA_Q
#undef XA_SYNC
#undef XA_ROT
#undef XID
}

__device__ __forceinline__ void final_row(float* row, const float* g, int lane) {
    f32x4* xr = (f32x4*)row + lane; const f32x4* gr = (const f32x4*)g + lane;
    f32x4 v[4]; float s = 0.f;
#pragma unroll
    for (int j = 0; j < 4; ++j) { v[j] = xr[64 * j]; s += (v[j].x * v[j].x + v[j].y * v[j].y) + (v[j].z * v[j].z + v[j].w * v[j].w); }
    const float rs = 1.f / sqrtf(wave_sum(s) * (1.f / DM) + EPS);
#pragma unroll
    for (int j = 0; j < 4; ++j) xr[64 * j] = v[j] * rs * gr[64 * j];
}

struct Args { const float* in[26]; float* out; unsigned char* ws; int ph_lo, ph_hi, flags, pad; };
constexpr int NPHASE = 10;
#ifndef DUP_P1
#define DUP_P1 1
#endif
#ifndef DUP_P4
#define DUP_P4 1
#endif
#ifndef DUP_P5
#define DUP_P5 1
#endif
#ifndef DUP_P8
#define DUP_P8 1
#endif
#ifndef DUP_ATT
#define DUP_ATT 1
#endif
#ifndef DUP_LRU
#define DUP_LRU 1
#endif
#ifndef DUP_X
#define DUP_X 1
#endif
__global__ void __launch_bounds__(512, 2) mk_fwd(Args args) {
    extern __shared__ __attribute__((aligned(16))) unsigned char lds_raw[];
    Frame F;
    F.lds = (LAS unsigned char*)lds_raw;
    F.tid = threadIdx.x; F.lane = F.tid & 63; F.wave = __builtin_amdgcn_readfirstlane(F.tid >> 6);
    F.G = gridDim.x; F.bid = blockIdx.x;
    F.out = args.out; F.ws = args.ws;
    unsigned char* ws = args.ws;
    const int lo = args.ph_lo, hi = args.ph_hi;
    volatile LAS unsigned* MISC = (volatile LAS unsigned*)(F.lds + LDS_MISC_OFF);
    if (F.tid < 64) MISC[F.tid] = 0u;
    __syncthreads();
    XcdBarrier bar = xcd_barrier_post((unsigned*)ws, MISC + 8);
#define IN(k) (lo <= (k) && (k) < hi)
#define SEAM(k) do { if (IN(k) && IN((k) + 1)) xcd_barrier(bar); } while (0)
    typedef pg8::StaticOrder SO;

    if (IN(0)) { p0_prologue(F); }
    SEAM(0);
    if (IN(1)) {
        { pg8::Gemm g{(const pg8::bf16_t*)(ws + WS_XN), (const pg8::bf16_t*)(ws + WS_WA), T, 2048, DM}; SO S; S.init(T, 2048, F.G, F.bid);
          pg8::EpiBf E{(pg8::bf16_t*)(ws + WS_PA), PAW, nullptr, 512, 0.125f * LOG2E, false, (const float*)(ws + WS_RS0), 1}; pg8::gemm_phase<pg8::EpiBf, SO, true, true>(F.lds, g, S, E); }
        { pg8::Gemm g{(const pg8::bf16_t*)(ws + WS_WV), (const pg8::bf16_t*)(ws + WS_XN), 512, T, DM}; SO S; S.init(512, T, F.G, F.bid);
          pg8::EpiBf E{(pg8::bf16_t*)(ws + WS_VT), T, nullptr, 0, 1.0f, true, (const float*)(ws + WS_RS0), 2}; pg8::gemm_phase<pg8::EpiBf, SO, true, true>(F.lds, g, S, E); }
    }
    SEAM(1);
    if (IN(2)) {
        if (!(args.flags & 16)) for (int rep = 0; rep < DUP_ATT; ++rep) attn_phase(F);
        __syncthreads();
        if (!(args.flags & 8)) for (int rep = 0; rep < DUP_LRU; ++rep) for (int it = F.bid; it < NB * NCH; it += F.G) lru1_item(F, it / NCH, it % NCH);
        __syncthreads();
    }
    SEAM(2);
    if (IN(3)) { for (int p = F.bid; p < NB * NCH / 2; p += F.G) { float cH[8]; const int b = p / (NCH / 2), c0 = 2 * (p % (NCH / 2));
            lru3_item(F, b, c0, false, cH); lru3_item(F, b, c0 + 1, true, cH); } }
    SEAM(3);
    if (IN(4)) { pg8::Gemm g{(const pg8::bf16_t*)(ws + WS_MERGED), (const pg8::bf16_t*)(ws + WS_WOUT), T, DM, DM}; SO S; S.init(T, DM, F.G, F.bid);
        pg8::EpiRes<false> E{nullptr, (const pg8::bf16_t*)(ws + WS_XN), (pg8::bf16_t*)(ws + WS_XB), (float*)(ws + WS_SS1)}; pg8::gemm_phase<pg8::EpiRes<false>, SO, true, true>(F.lds, g, S, E); }
    SEAM(4);
    if (IN(5)) { pg8::Gemm g{(const pg8::bf16_t*)(ws + WS_XB), (const pg8::bf16_t*)(ws + WS_WQ), T, DM, DM}; SO S; S.init(T, DM, F.G, F.bid);
        pg8::EpiBf E{(pg8::bf16_t*)(ws + WS_QX), DM, (const float*)(ws + WS_SS1), 0, 1.0f, false}; pg8::gemm_phase<pg8::EpiBf, SO, true, true>(F.lds, g, S, E);
        asm volatile("s_waitcnt vmcnt(0)" ::: "memory"); __syncthreads();
        if (!(args.flags & 1)) xattn_phase(F, S); }
    SEAM(6);
    if (IN(7)) { pg8::Gemm g{(const pg8::bf16_t*)(ws + WS_OX), (const pg8::bf16_t*)(ws + WS_WO), T, DM, DM}; SO S; S.init(T, DM, F.G, F.bid);
        pg8::EpiRes<false> E{nullptr, (const pg8::bf16_t*)(ws + WS_XB), (pg8::bf16_t*)(ws + WS_XB2), (float*)(ws + WS_SS2)}; pg8::gemm_phase<pg8::EpiRes<false>, SO, true, true>(F.lds, g, S, E); }
    SEAM(7);
    if (IN(8)) { pg8::Gemm g{(const pg8::bf16_t*)(ws + WS_XB2), (const pg8::bf16_t*)(ws + WS_WGU), T, 2 * DFF, DM}; SO S; S.init(T, 2 * DFF, F.G, F.bid);
        pg8::EpiSwiGLU E{(pg8::bf16_t*)(ws + WS_ACT), DFF, (const float*)(ws + WS_SS2)}; pg8::gemm_phase<pg8::EpiSwiGLU, SO, true, true>(F.lds, g, S, E); }
    SEAM(8);
    if (IN(9)) { pg8::Gemm g{(const pg8::bf16_t*)(ws + WS_ACT), (const pg8::bf16_t*)(ws + WS_WDN), T, DM, DFF}; SO S; S.init(T, DM, F.G, F.bid);
        pg8::EpiFinal E{(const pg8::bf16_t*)(ws + WS_XB2), F.out, inp(I_GFINAL), (float*)(ws + WS_SS1), (unsigned*)(ws + 16384), args.flags}; pg8::gemm_phase<pg8::EpiFinal, SO, true, true>(F.lds, g, S, E); }
#undef IN
#undef SEAM
}

#ifndef MK_N_LAUNCHES
#define MK_N_LAUNCHES 1
#endif
extern "C" void kernel_launch(void* const* d_in, const int* in_sizes, int n_in, void* d_out, int out_size, void* d_ws, size_t ws_size, hipStream_t stream) {
    static int grid = 0;
    if (grid == 0) {
        if (n_in != 26 || in_sizes[0] != T * DM || out_size != T * DM || ws_size < WS_END) { fprintf(stderr, "kernel_launch: unexpected shapes (n_in %d, ws %zu); nothing launched\n", n_in, ws_size); grid = -1; return; }
        int dev = 0, cus = 0, per_cu = 0;
        if (hipGetDevice(&dev) != hipSuccess || hipDeviceGetAttribute(&cus, hipDeviceAttributeMultiprocessorCount, dev) != hipSuccess) { grid = -1; return; }
        if (hipFuncSetAttribute((const void*)mk_fwd, hipFuncAttributeMaxDynamicSharedMemorySize, LDS_BYTES) != hipSuccess) { fprintf(stderr, "kernel_launch: hipFuncSetAttribute failed\n"); grid = -1; return; }
        if (hipOccupancyMaxActiveBlocksPerMultiprocessor(&per_cu, (const void*)mk_fwd, 512, LDS_BYTES) != hipSuccess || per_cu < 1) { fprintf(stderr, "kernel_launch: occupancy query says %d\n", per_cu); per_cu = 1; }
        (void)hipGetLastError();
        grid = cus;
    }
    if (grid < 0) return;
    Args a{};
    for (int i = 0; i < 26; ++i) a.in[i] = (const float*)d_in[i];
    a.out = (float*)d_out; a.ws = (unsigned char*)d_ws;
    if (MK_N_LAUNCHES == 1) {
        a.ph_lo = 0; a.ph_hi = NPHASE;
        if (hipMemsetAsync(d_ws, 0, 65536, stream) != hipSuccess) { fprintf(stderr, "kernel_launch: memset failed\n"); return; }
        hipLaunchKernelGGL(mk_fwd, dim3(grid), dim3(512), LDS_BYTES, stream, a);
    } else {
        if (hipMemsetAsync(d_ws, 0, 65536, stream) != hipSuccess) return;
        for (int p = 0; p < NPHASE; ++p) { if (p == 6) continue;
            a.ph_lo = p; a.ph_hi = p + 1; hipLaunchKernelGGL(mk_fwd, dim3(grid), dim3(512), LDS_BYTES, stream, a);
#ifdef MK_PROBE_PHASE
            if (p == MK_PROBE_PHASE) {
#ifdef MK_PROBE_FLAGS
                a.flags = MK_PROBE_FLAGS;
#endif
                hipLaunchKernelGGL(mk_fwd, dim3(grid), dim3(512), LDS_BYTES, stream, a); a.flags = 0; }
#endif
        }
    }
}
```

```cpp
#include <hip/hip_runtime.h>
#include <cstdio>
#include <cstdint>
namespace pg8 {
#define PG8_LAS __attribute__((address_space(3)))
typedef unsigned short bf16_t;
typedef short bf16x8 __attribute__((ext_vector_type(8)));
typedef float f32x4 __attribute__((ext_vector_type(4)));
typedef unsigned u32x4 __attribute__((ext_vector_type(4)));
constexpr int BM = 256, BK = 64, HALF = 128, HTB = HALF * BK * 2  , STAGE_BYTES = 8 * HTB, NXCD = 8, WGM = 4;

__host__ __device__ __forceinline__ int lds_byte(int r, int c) { const int st = (r >> 4) * 2 + (c >> 5), rr = r & 15, cc = c & 31, ob = rr * 64 + cc * 2; return st * 1024 + (ob ^ (((ob >> 9) & 1) << 5)); }
__host__ __device__ __forceinline__ void stage_rc(int b, int& R, int& C) { const int st = b / 1024, sb = b % 1024, swz = sb ^ (((sb >> 9) & 1) << 5); R = (st >> 1) * 16 + swz / 64; C = (st & 1) * 32 + (swz % 64) / 2; }
__host__ __device__ __forceinline__ int perm32(int rho) { const int n = rho >> 4, i = rho & 15; return 8 * (i >> 2) + 4 * n + (i & 3); }

struct Unit { int pm, pn; };
struct Gemm { const bf16_t* A; const bf16_t* Bt; int M, N, K; };

struct StaticOrder {
    int nM, nN, nwg, G, c;
    __host__ __device__ void init(int M, int N, int G_, int c_) { nM = M / BM; nN = N / BM; nwg = nM * nN; G = G_; c = c_; }
    __host__ __device__ bool next(int i, Unit& u) const {
        const long L = (long)i * G + c; if (L >= nwg) return false;
        int wgid = (int)L; { const int q = nwg / NXCD, r = nwg % NXCD, xcd = wgid % NXCD, off = wgid / NXCD; wgid = (xcd < r ? xcd * (q + 1) : r * (q + 1) + (xcd - r) * q) + off; }
        const int nig = WGM * nN, gid = wgid / nig, fm = gid * WGM, gsz = (nM - fm) < WGM ? (nM - fm) : WGM;
        u.pm = fm + ((wgid % nig) % gsz); u.pn = (wgid % nig) / gsz; return true;
    }
    __device__ __forceinline__ void a_ready(const Unit&) const {}
    __device__ __forceinline__ void done(const Unit&) const {}
};

__device__ __forceinline__ unsigned cvt_pk_bf16(float lo, float hi) { unsigned r; asm volatile("v_cvt_pk_bf16_f32 %0, %1, %2" : "=v"(r) : "v"(lo), "v"(hi)); return r; }
typedef float f32x2 __attribute__((ext_vector_type(2)));
typedef unsigned u32x4e __attribute__((ext_vector_type(4)));
__device__ __forceinline__ float xor32e(float v) { const unsigned u = __builtin_bit_cast(unsigned, v); auto rr = __builtin_amdgcn_permlane32_swap(u, u, false, false); return __builtin_bit_cast(float, (unsigned)(rr[0] ^ rr[1] ^ u)); }
__device__ __forceinline__ float row_rs16(const float* ss, int row, int fq) {
    const f32x4 a = *(const f32x4*)(ss + (size_t)row * 16 + 4 * fq);
    float s = (a[0] + a[1]) + (a[2] + a[3]);
    s += __shfl_xor(s, 16); s += xor32e(s);
    return 1.0f / sqrtf(s * (1.0f / 1024.0f) + 1e-6f);
}
struct EpiBf {
    static constexpr bool PERM = true, AFTER_DRAIN = false;
    bf16_t* O; int ldc; const float* ss; int qcols; float qs; bool perm16; const float* rsv = nullptr; int rsmode = 0;
    __device__ __forceinline__ void operator()(const f32x4 (&acc)[2][2][4][2], const Unit& u, int wr, int wc, int fr, int fq) const {
        const int row0 = u.pm * BM + wr * 64 + fr, col0 = u.pn * BM + wc * 32 + 8 * fq;
        const float cs = (u.pn * BM < qcols) ? qs : 1.0f;
#pragma unroll
        for (int ai = 0; ai < 2; ++ai)
#pragma unroll
            for (int m = 0; m < 4; ++m) { const int row = row0 + ai * HALF + m * 16; bf16_t* rowp = O + (size_t)row * ldc + col0;
                const float sc = (ss ? row_rs16(ss, row, fq) : 1.0f) * cs * (rsmode == 1 ? rsv[row] : 1.0f);
#pragma unroll
                for (int bj = 0; bj < 2; ++bj) { f32x4 v0 = acc[ai][bj][m][0] * sc, v1 = acc[ai][bj][m][1] * sc;
                    if (rsmode == 2) { v0 = v0 * *(const f32x4*)(rsv + col0 + bj * HALF); v1 = v1 * *(const f32x4*)(rsv + col0 + bj * HALF + 4); }
                    u32x4e w; w.x = cvt_pk_bf16(v0[0], v0[1]); w.y = cvt_pk_bf16(v0[2], v0[3]); w.z = cvt_pk_bf16(v1[0], v1[1]); w.w = cvt_pk_bf16(v1[2], v1[3]);
                    if (perm16) { typedef unsigned u32x2e __attribute__((ext_vector_type(2))); bf16_t* gp = rowp + bj * HALF - 8 * (fq & 1);
                        *(u32x2e*)(gp + 4 * (fq & 1)) = (u32x2e){w.x, w.y}; *(u32x2e*)(gp + 8 + 4 * (fq & 1)) = (u32x2e){w.z, w.w}; }
                    else *(u32x4e*)(rowp + bj * HALF) = w; } }
    }
};
__device__ __forceinline__ f32x4 bf_lo4(unsigned a, unsigned b) { return (f32x4){__builtin_bit_cast(float, a << 16), __builtin_bit_cast(float, a & 0xffff0000u), __builtin_bit_cast(float, b << 16), __builtin_bit_cast(float, b & 0xffff0000u)}; }
template <bool BASE_F32> struct EpiRes {
    static constexpr bool PERM = true, AFTER_DRAIN = false;
    const float* basef; const bf16_t* xin; bf16_t* xb; float* ss;
    __device__ __forceinline__ void operator()(const f32x4 (&acc)[2][2][4][2], const Unit& u, int wr, int wc, int fr, int fq) const {
        const int row0 = u.pm * BM + wr * 64 + fr, col0 = u.pn * BM + wc * 32 + 8 * fq;
        if constexpr (BASE_F32) {
#pragma unroll
            for (int ai = 0; ai < 2; ++ai) {
                f32x4 pre[4][2][2];
#pragma unroll
                for (int m = 0; m < 4; ++m)
#pragma unroll
                    for (int bj = 0; bj < 2; ++bj) { const size_t off = (size_t)(row0 + ai * HALF + m * 16) * 1024 + col0 + bj * HALF; pre[m][bj][0] = *(const f32x4*)(basef + off); pre[m][bj][1] = *(const f32x4*)(basef + off + 4); }
                __builtin_amdgcn_sched_barrier(0);
#pragma unroll
                for (int m = 0; m < 4; ++m) { const int row = row0 + ai * HALF + m * 16; const size_t off = (size_t)row * 1024 + col0; float q = 0.f;
#pragma unroll
                    for (int bj = 0; bj < 2; ++bj) { const f32x4 v0 = acc[ai][bj][m][0] + pre[m][bj][0], v1 = acc[ai][bj][m][1] + pre[m][bj][1];
                        q += ((v0[0] * v0[0] + v0[1] * v0[1]) + (v0[2] * v0[2] + v0[3] * v0[3])) + ((v1[0] * v1[0] + v1[1] * v1[1]) + (v1[2] * v1[2] + v1[3] * v1[3]));
                        u32x4e w; w.x = cvt_pk_bf16(v0[0], v0[1]); w.y = cvt_pk_bf16(v0[2], v0[3]); w.z = cvt_pk_bf16(v1[0], v1[1]); w.w = cvt_pk_bf16(v1[2], v1[3]);
                        *(u32x4e*)(xb + off + bj * HALF) = w; }
                    q += __shfl_xor(q, 16); q += xor32e(q); if (fq == 0) ss[(size_t)row * 16 + u.pn * 4 + wc] = q; }
                __builtin_amdgcn_sched_barrier(0);
            }
        } else {
            u32x4e pre[2][4][2];
#pragma unroll
            for (int ai = 0; ai < 2; ++ai)
#pragma unroll
                for (int m = 0; m < 4; ++m)
#pragma unroll
                    for (int bj = 0; bj < 2; ++bj) pre[ai][m][bj] = *(const u32x4e*)(xin + (size_t)(row0 + ai * HALF + m * 16) * 1024 + col0 + bj * HALF);
            __builtin_amdgcn_sched_barrier(0);
#pragma unroll
            for (int ai = 0; ai < 2; ++ai)
#pragma unroll
                for (int m = 0; m < 4; ++m) { const int row = row0 + ai * HALF + m * 16; const size_t off = (size_t)row * 1024 + col0; float q = 0.f;
#pragma unroll
                    for (int bj = 0; bj < 2; ++bj) { const u32x4e pw = pre[ai][m][bj];
                        const f32x4 v0 = acc[ai][bj][m][0] + bf_lo4(pw.x, pw.y), v1 = acc[ai][bj][m][1] + bf_lo4(pw.z, pw.w);
                        q += ((v0[0] * v0[0] + v0[1] * v0[1]) + (v0[2] * v0[2] + v0[3] * v0[3])) + ((v1[0] * v1[0] + v1[1] * v1[1]) + (v1[2] * v1[2] + v1[3] * v1[3]));
                        u32x4e w; w.x = cvt_pk_bf16(v0[0], v0[1]); w.y = cvt_pk_bf16(v0[2], v0[3]); w.z = cvt_pk_bf16(v1[0], v1[1]); w.w = cvt_pk_bf16(v1[2], v1[3]);
                        *(u32x4e*)(xb + off + bj * HALF) = w; }
                    q += __shfl_xor(q, 16); q += xor32e(q); if (fq == 0) ss[(size_t)row * 16 + u.pn * 4 + wc] = q; }
        }
    }
};
struct EpiFinal {
    static constexpr bool PERM = true, AFTER_DRAIN = false;
    const bf16_t* xb; float* out; const float* g; float* ss; unsigned* cnt; int dbg;
    __device__ __forceinline__ void operator()(f32x4 (&acc)[2][2][4][2], const Unit& u, int wr, int wc, int fr, int fq) const {
        const int row0 = u.pm * BM + wr * 64 + fr, col0 = u.pn * BM + wc * 32 + 8 * fq;
        u32x4e pre[2][4][2];
#pragma unroll
        for (int ai = 0; ai < 2; ++ai)
#pragma unroll
            for (int m = 0; m < 4; ++m)
#pragma unroll
                for (int bj = 0; bj < 2; ++bj) pre[ai][m][bj] = *(const u32x4e*)(xb + (size_t)(row0 + ai * HALF + m * 16) * 1024 + col0 + bj * HALF);
        __builtin_amdgcn_sched_barrier(0);
#pragma unroll
        for (int ai = 0; ai < 2; ++ai)
#pragma unroll
            for (int m = 0; m < 4; ++m) { const int row = row0 + ai * HALF + m * 16; float q = 0.f;
#pragma unroll
                for (int bj = 0; bj < 2; ++bj) { const u32x4e w = pre[ai][m][bj];
                    const f32x4 b0 = bf_lo4(w.x, w.y), b1 = bf_lo4(w.z, w.w);
                    const f32x4 v0 = acc[ai][bj][m][0] + b0, v1 = acc[ai][bj][m][1] + b1; acc[ai][bj][m][0] = v0; acc[ai][bj][m][1] = v1;
                    q += ((v0[0] * v0[0] + v0[1] * v0[1]) + (v0[2] * v0[2] + v0[3] * v0[3])) + ((v1[0] * v1[0] + v1[1] * v1[1]) + (v1[2] * v1[2] + v1[3] * v1[3])); }
                q += __shfl_xor(q, 16); q += xor32e(q);
                if (fq == 0) __hip_atomic_store(ss + (size_t)row * 16 + u.pn * 4 + wc, q, __ATOMIC_RELAXED, __HIP_MEMORY_SCOPE_AGENT); }
        asm volatile("s_waitcnt vmcnt(0)" ::: "memory");
        unsigned* c = cnt + 64 * u.pm;
        if (!(dbg & 2)) {
        if ((fr | fq) == 0) __hip_atomic_fetch_add(c, 1u, __ATOMIC_RELAXED, __HIP_MEMORY_SCOPE_AGENT);
        { unsigned sp = 0; while (__hip_atomic_load(c, __ATOMIC_RELAXED, __HIP_MEMORY_SCOPE_AGENT) < 32u) { __builtin_amdgcn_s_sleep(16); if (++sp > (1u << 20)) break; } }
        }
        const int gc = u.pn * BM + wc * 32 + 8 * fq;
        f32x4 gv[2][2];
#pragma unroll
        for (int bj = 0; bj < 2; ++bj) { gv[bj][0] = *(const f32x4*)(g + gc + bj * HALF); gv[bj][1] = *(const f32x4*)(g + gc + bj * HALF + 4); }
#pragma unroll
        for (int ai = 0; ai < 2; ++ai)
#pragma unroll
            for (int m = 0; m < 4; ++m) { const int row = row0 + ai * HALF + m * 16; const size_t off = (size_t)row * 1024 + col0; float s = 0.f;
#pragma unroll
                for (int k = 0; k < 2; ++k) { const unsigned long long w = __hip_atomic_load((const unsigned long long*)(ss + (size_t)row * 16 + 4 * fq) + k, __ATOMIC_RELAXED, __HIP_MEMORY_SCOPE_AGENT);
                    s += __uint_as_float((unsigned)w) + __uint_as_float((unsigned)(w >> 32)); }
                s += __shfl_xor(s, 16); s += xor32e(s);
                const float rs = 1.0f / sqrtf(s * (1.0f / 1024.0f) + 1e-6f);
                if (!(dbg & 4))
#pragma unroll
                for (int bj = 0; bj < 2; ++bj) { *(f32x4*)(out + off + bj * HALF) = acc[ai][bj][m][0] * rs * gv[bj][0]; *(f32x4*)(out + off + bj * HALF + 4) = acc[ai][bj][m][1] * rs * gv[bj][1]; } }
    }
};
struct EpiSwiGLU {
    static constexpr bool PERM = true, AFTER_DRAIN = false;
    bf16_t* O; int ldc; const float* ss;
    __device__ __forceinline__ void operator()(const f32x4 (&acc)[2][2][4][2], const Unit& u, int wr, int wc, int fr, int fq) const {
        const int row0 = u.pm * BM + wr * 64 + fr, col0 = u.pn * HALF + wc * 32 + 8 * fq;
#pragma unroll
        for (int ai = 0; ai < 2; ++ai)
#pragma unroll
            for (int m = 0; m < 4; ++m) { const int row = row0 + ai * HALF + m * 16; const float sc = row_rs16(ss, row, fq);
                float a[8];
#pragma unroll
                for (int n = 0; n < 2; ++n)
#pragma unroll
                    for (int e = 0; e < 4; ++e) { const float g = acc[ai][0][m][n][e] * sc, up = acc[ai][1][m][n][e] * sc;
                        const float sg = g * __builtin_amdgcn_rcpf(1.0f + __builtin_amdgcn_exp2f(-1.4426950408889634f * g)); a[4 * n + e] = sg * up; }
                u32x4e w; w.x = cvt_pk_bf16(a[0], a[1]); w.y = cvt_pk_bf16(a[2], a[3]); w.z = cvt_pk_bf16(a[4], a[5]); w.w = cvt_pk_bf16(a[6], a[7]);
                *(u32x4e*)(O + (size_t)row * ldc + col0) = w; }
    }
};
template <class Epi, class Sched, bool ALIGN_EPI = false, bool SP2 = false>
__device__ __forceinline__ void gemm_phase(PG8_LAS unsigned char* lds, const Gemm g, const Sched& S, const Epi& E) {
    const int tid = threadIdx.x, wid = __builtin_amdgcn_readfirstlane(tid >> 6), lane = tid & 63, wr = wid >> 2, wc = wid & 3, fr = lane & 15, fq = lane >> 4;
    const int K = g.K, nt = K / BK;
    unsigned voffA[2], voffB[2];
#pragma unroll
    for (int i = 0; i < 2; ++i) { int R, C; stage_rc(tid * 16 + i * 8192, R, C); const int Rb = Epi::PERM ? ((R & ~31) + perm32(R & 31)) : R;
        voffA[i] = (unsigned)(R * K + C) * 2u; voffB[i] = (unsigned)(Rb * K + C) * 2u; }
    const size_t kstep = (size_t)(BK * 2);
    const size_t hstep = (size_t)HALF * K * 2;
    const size_t tstep = 2 * hstep;
    const unsigned ldsw = (unsigned)wid * 1024u;
    const int aoff = lds_byte(wr * 64 + fr, fq * 8), boff = lds_byte(wc * 32 + fr, fq * 8);
#define PG8_SA(b, h) (((b) * 2 + (h)) * HTB)
#define PG8_SB(b, h) ((4 + (b) * 2 + (h)) * HTB)
#define PG8_STAGE(bufoff, gbase, voff) do { _Pragma("unroll") for (int _i = 0; _i < 2; ++_i) \
        __builtin_amdgcn_global_load_lds((const unsigned*)((const char*)(gbase) + (voff)[_i]), (PG8_LAS unsigned*)(lds + (bufoff) + ldsw + _i * 8192), 16, 0, 0); } while (0)
#define PG8_LDA(dst, b, h) do { _Pragma("unroll") for (int m = 0; m < 4; ++m) _Pragma("unroll") for (int k = 0; k < 2; ++k) dst[m][k] = *(const PG8_LAS bf16x8*)(lds + PG8_SA(b, h) + aoff + m * 2048 + k * 1024); } while (0)
#define PG8_LDB(dst, b, h) do { _Pragma("unroll") for (int n = 0; n < 2; ++n) _Pragma("unroll") for (int k = 0; k < 2; ++k) dst[n][k] = *(const PG8_LAS bf16x8*)(lds + PG8_SB(b, h) + boff + n * 2048 + k * 1024); } while (0)
#define PG8_MMA(ai, bj, At, Bt) do { __builtin_amdgcn_s_setprio(1); _Pragma("unroll") for (int m = 0; m < 4; ++m) _Pragma("unroll") for (int n = 0; n < 2; ++n) _Pragma("unroll") for (int k = 0; k < 2; ++k) \
        acc[ai][bj][m][n] = __builtin_amdgcn_mfma_f32_16x16x32_bf16(Bt[n][k], At[m][k], acc[ai][bj][m][n], 0, 0, 0); __builtin_amdgcn_s_setprio(0); } while (0)
#define PG8_WAIT_V(n) asm volatile("s_waitcnt vmcnt(" #n ")" ::: "memory")
#define PG8_WAIT_L(n) asm volatile("s_waitcnt lgkmcnt(" #n ")" ::: "memory")
#define PG8_BAR __builtin_amdgcn_s_barrier()
#define PG8_SCHED __builtin_amdgcn_sched_barrier(0)
    Unit cur, nxt; int ui = 0;
    if (!S.next(0, cur)) return;
    f32x4 acc[2][2][4][2];
#pragma unroll
    for (int a = 0; a < 2; ++a)
#pragma unroll
        for (int b = 0; b < 2; ++b)
#pragma unroll
            for (int m = 0; m < 4; ++m)
#pragma unroll
                for (int n = 0; n < 2; ++n) acc[a][b][m][n] = (f32x4){0.f, 0.f, 0.f, 0.f};
    bf16x8 At[4][2], B0[2][2], B1[2][2];
    const char* cA = (const char*)g.A + (size_t)cur.pm * tstep; const char* cB = (const char*)g.Bt + (size_t)cur.pn * tstep;
    S.a_ready(cur);
    if constexpr (SP2) {
        PG8_STAGE(PG8_SB(0, 0), cB, voffB); PG8_STAGE(PG8_SB(0, 1), cB + hstep, voffB); PG8_STAGE(PG8_SA(0, 0), cA, voffA); PG8_STAGE(PG8_SA(0, 1), cA + hstep, voffA);
        if (wr == 1) PG8_BAR;
        PG8_WAIT_V(2); PG8_BAR;
        PG8_STAGE(PG8_SB(1, 0), cB + kstep, voffB); PG8_STAGE(PG8_SA(1, 0), cA + kstep, voffA); PG8_STAGE(PG8_SB(1, 1), cB + hstep + kstep, voffB);
        PG8_WAIT_V(6); PG8_BAR;
    } else {
        PG8_STAGE(PG8_SB(0, 0), cB, voffB); PG8_STAGE(PG8_SA(0, 0), cA, voffA); PG8_STAGE(PG8_SB(0, 1), cB + hstep, voffB); PG8_STAGE(PG8_SA(0, 1), cA + hstep, voffA);
        if (wr == 1) PG8_BAR;
        PG8_WAIT_V(4); PG8_BAR;
        PG8_STAGE(PG8_SB(1, 0), cB + kstep, voffB); PG8_STAGE(PG8_SA(1, 0), cA + kstep, voffA); PG8_STAGE(PG8_SB(1, 1), cB + hstep + kstep, voffB);
        PG8_WAIT_V(6); PG8_BAR;
    }
    for (;;) {
        const bool has_next = S.next(ui + 1, nxt);
        const char* nA = has_next ? (const char*)g.A + (size_t)nxt.pm * tstep : cA; const char* nB = has_next ? (const char*)g.Bt + (size_t)nxt.pn * tstep : cB;
        for (int t = 0; t < nt; t += 2) {
            const bool last = (t == nt - 2);
            const char* a1 = cA + (size_t)(t + 1) * kstep;
            const char* a2 = last ? nA : cA + (size_t)(t + 2) * kstep; const char* b2 = last ? nB : cB + (size_t)(t + 2) * kstep;
            const char* a3 = a2 + kstep; const char* b3 = b2 + kstep;
            if (last && has_next) S.a_ready(nxt);
            if constexpr (SP2) {
            PG8_LDB(B0, 0, 0); PG8_LDB(B1, 0, 1); PG8_SCHED; PG8_LDA(At, 0, 0); PG8_STAGE(PG8_SA(1, 1), a1 + hstep, voffA);
            PG8_WAIT_V(8); PG8_WAIT_L(0); PG8_BAR; PG8_MMA(0, 0, At, B0); PG8_MMA(0, 1, At, B1); PG8_BAR; PG8_SCHED;
            PG8_LDA(At, 0, 1); PG8_STAGE(PG8_SB(0, 0), b2, voffB); PG8_STAGE(PG8_SB(0, 1), b2 + hstep, voffB); PG8_STAGE(PG8_SA(0, 0), a2, voffA);
            PG8_WAIT_V(8); PG8_WAIT_L(0); PG8_BAR; PG8_MMA(1, 0, At, B0); PG8_MMA(1, 1, At, B1); PG8_BAR; PG8_SCHED;
            PG8_LDB(B0, 1, 0); PG8_LDB(B1, 1, 1); PG8_SCHED; PG8_LDA(At, 1, 0); PG8_STAGE(PG8_SA(0, 1), a2 + hstep, voffA);
            PG8_WAIT_V(8); PG8_WAIT_L(0); PG8_BAR; PG8_MMA(0, 0, At, B0); PG8_MMA(0, 1, At, B1); PG8_BAR; PG8_SCHED;
            PG8_LDA(At, 1, 1); PG8_STAGE(PG8_SB(1, 0), b3, voffB); PG8_STAGE(PG8_SB(1, 1), b3 + hstep, voffB); PG8_STAGE(PG8_SA(1, 0), a3, voffA);
            PG8_WAIT_V(8); PG8_WAIT_L(0); PG8_BAR; PG8_MMA(1, 0, At, B0); PG8_MMA(1, 1, At, B1); PG8_BAR; PG8_SCHED;
            } else {
            PG8_LDB(B0, 0, 0); PG8_SCHED; PG8_LDA(At, 0, 0); PG8_STAGE(PG8_SA(1, 1), a1 + hstep, voffA);
            PG8_WAIT_L(8); PG8_BAR; PG8_WAIT_L(0); PG8_MMA(0, 0, At, B0); PG8_BAR; PG8_SCHED;
            PG8_LDB(B1, 0, 1); PG8_STAGE(PG8_SB(0, 0), b2, voffB);
            PG8_BAR; PG8_WAIT_L(0); PG8_MMA(0, 1, At, B1); PG8_BAR;
            PG8_LDA(At, 0, 1); PG8_STAGE(PG8_SA(0, 0), a2, voffA);
            PG8_BAR; PG8_WAIT_L(0); PG8_MMA(1, 0, At, B0); PG8_BAR; PG8_SCHED;
            PG8_STAGE(PG8_SB(0, 1), b2 + hstep, voffB);
            PG8_WAIT_V(6); PG8_BAR; PG8_MMA(1, 1, At, B1); PG8_BAR;
            PG8_LDB(B0, 1, 0); PG8_SCHED; PG8_LDA(At, 1, 0); PG8_STAGE(PG8_SA(0, 1), a2 + hstep, voffA);
            PG8_WAIT_L(8); PG8_BAR; PG8_WAIT_L(0); PG8_MMA(0, 0, At, B0); PG8_BAR; PG8_SCHED;
            PG8_LDB(B1, 1, 1); PG8_STAGE(PG8_SB(1, 0), b3, voffB);
            PG8_BAR; PG8_WAIT_L(0); PG8_MMA(0, 1, At, B1); PG8_BAR;
            PG8_LDA(At, 1, 1); PG8_STAGE(PG8_SA(1, 0), a3, voffA);
            PG8_BAR; PG8_WAIT_L(0); PG8_MMA(1, 0, At, B0); PG8_BAR; PG8_SCHED;
            PG8_STAGE(PG8_SB(1, 1), b3 + hstep, voffB);
            PG8_WAIT_V(6); PG8_BAR; PG8_MMA(1, 1, At, B1); PG8_BAR;
            }
        }
        if constexpr (ALIGN_EPI) { if (wr == 0) PG8_BAR; }
        if constexpr (!Epi::AFTER_DRAIN) { E(acc, cur, wr, wc, fr, fq); S.done(cur); }
        if (!has_next) break;
#pragma unroll
        for (int a = 0; a < 2; ++a)
#pragma unroll
            for (int b = 0; b < 2; ++b)
#pragma unroll
                for (int m = 0; m < 4; ++m)
#pragma unroll
                    for (int n = 0; n < 2; ++n) acc[a][b][m][n] = (f32x4){0.f, 0.f, 0.f, 0.f};
        cur = nxt; cA = nA; cB = nB; ++ui;
        if constexpr (ALIGN_EPI) { if (wr == 1) PG8_BAR; }
    }
    PG8_WAIT_V(0);
    if constexpr (!ALIGN_EPI) { if (wr == 0) PG8_BAR; }
    PG8_BAR;
    if constexpr (Epi::AFTER_DRAIN) { E.fused(acc, cur, wr, wc, fr, fq, lds, wid, lane); S.done(cur); }
#undef PG8_SA
#undef PG8_SB
#undef PG8_STAGE
#undef PG8_LDA
#undef PG8_LDB
#undef PG8_MMA
#undef PG8_WAIT_V
#undef PG8_WAIT_L
#undef PG8_BAR
#undef PG8_SCHED
}
}

constexpr int NB = 4, SEQ = 8192, DM = 1024, T = NB * SEQ;
constexpr int NCH = SEQ / 64;
constexpr int NMEM = 256, DFF = 2816, DLRU = 512;
constexpr int PAW = 2048;
constexpr float EPS = 1e-6f, LOG2E = 1.4426950408889634f;

constexpr size_t MiB = 1u << 20;
constexpr size_t WS_WA = 2 * MiB, WS_WV = 6 * MiB, WS_WOUT = 7 * MiB, WS_WQ = 9 * MiB, WS_WK = 11 * MiB, WS_WVC = 13 * MiB, WS_WO = 15 * MiB,
                 WS_WGU = 17 * MiB, WS_WDN = 28 * MiB, WS_WRG = 34 * MiB, WS_WIG = 34 * MiB + 65536;
constexpr size_t WS_MN = 36 * MiB, WS_KX = 38 * MiB, WS_VXT = 40 * MiB, WS_SS1 = 42 * MiB, WS_SS2 = 44 * MiB, WS_LP = 46 * MiB, WS_LH = 47 * MiB;
constexpr size_t WS_PA = 48 * MiB, WS_VT = 176 * MiB, WS_XN = 208 * MiB, WS_MERGED = 272 * MiB, WS_XB = 336 * MiB, WS_HLOC = 400 * MiB, WS_END = 464 * MiB;
constexpr size_t WS_RS0 = 35 * MiB;
constexpr size_t WS_XB2 = WS_HLOC;
constexpr size_t WS_ATT = WS_XB, WS_ASS = WS_SS2;
constexpr size_t WS_ACUM = WS_XN;
constexpr size_t WS_QX = WS_XN, WS_OX = WS_MERGED, WS_ACT = WS_PA;
static_assert(WS_ACT + (size_t)T * DFF * 2 <= WS_MERGED, "ACT overlay");

constexpr int LDS_BYTES = 147456, LDS_MISC_OFF = 143360;
#define GAS __attribute__((address_space(1)))
#define LAS __attribute__((address_space(3)))
typedef unsigned short bf16;
typedef unsigned v4u __attribute__((ext_vector_type(4)));
typedef unsigned v2u __attribute__((ext_vector_type(2)));
typedef float f32x4 __attribute__((ext_vector_type(4)));
typedef float f32x16 __attribute__((ext_vector_type(16)));
typedef short bf16x8 __attribute__((ext_vector_type(8)));
typedef short s16x4 __attribute__((ext_vector_type(4)));
typedef float f32x2_t __attribute__((ext_vector_type(2)));
typedef __bf16 bf16x2_t __attribute__((ext_vector_type(2)));
__device__ __forceinline__ unsigned pk2(float lo, float hi) { f32x2_t v = {lo, hi}; bf16x2_t b = __builtin_convertvector(v, bf16x2_t); return __builtin_bit_cast(unsigned, b); }
__device__ __forceinline__ float bf2f(unsigned short u) { return __builtin_bit_cast(float, (unsigned)u << 16); }
__device__ __forceinline__ int crow(int r, int hi) { return (r & 3) + 8 * (r >> 2) + 4 * hi; }
__device__ __forceinline__ bf16x8 pack8(const float* p) { v4u w; w.x = pk2(p[0], p[1]); w.y = pk2(p[2], p[3]); w.z = pk2(p[4], p[5]); w.w = pk2(p[6], p[7]); return __builtin_bit_cast(bf16x8, w); }
__device__ __forceinline__ float xor32_get(float v) { const unsigned u = __builtin_bit_cast(unsigned, v); auto rr = __builtin_amdgcn_permlane32_swap(u, u, false, false); return __builtin_bit_cast(float, (unsigned)(rr[0] ^ rr[1] ^ u)); }
__device__ __forceinline__ float wave_sum(float v) {
#pragma unroll
    for (int o = 1; o < 64; o <<= 1) v += __shfl_xor(v, o);
    return v;
}
#define MFMA32(a, b, c) __builtin_amdgcn_mfma_f32_32x32x16_bf16((a), (b), (c), 0, 0, 0)

#define RLX_AGENT __ATOMIC_RELAXED, __HIP_MEMORY_SCOPE_AGENT
#define XB_TMO      128
#define XB_XCNT(j)  (256  + 64 * (j))
#define XB_XSUB(j)  (1280 + 64 * (j))
#define XB_XGEN(j)  (2304 + 64 * (j))
#define XB_TOP      3328
#define XB_TOPGEN   3392
#define XCD_BAR_WORDS 3456
#define XB_SPIN_CAP (1u << 18)

__device__ __forceinline__ unsigned xb_ld(unsigned* p)              { return __hip_atomic_load(p, __ATOMIC_RELAXED, __HIP_MEMORY_SCOPE_AGENT); }
__device__ __forceinline__ unsigned xb_add(unsigned* p, unsigned v) { return __hip_atomic_fetch_add(p, v, __ATOMIC_RELAXED, __HIP_MEMORY_SCOPE_AGENT); }
__device__ __forceinline__ unsigned xb_xcc_id() { return (unsigned)__builtin_amdgcn_s_getreg((3 << 11) | 20) & 0xFu; }
#define XB_SPIN(cond, bar) do { unsigned _sp = 0; while (cond) { __builtin_amdgcn_s_sleep(1); \
    if ((++_sp & 255u) == 0u) { if (xb_ld(&(bar)[XB_TMO])) break; if (_sp > XB_SPIN_CAP) { atomicAdd(&(bar)[XB_TMO], 1u); break; } } } } while (0)

struct XcdBarrier {
    unsigned* bar; unsigned x;
    volatile LAS unsigned* st;
};

__device__ __forceinline__ XcdBarrier xcd_barrier_post(unsigned* bar, volatile LAS unsigned* st) {
    XcdBarrier b; b.bar = bar; b.x = xb_xcc_id(); b.st = st;
    if (threadIdx.x == 0) (void)xb_add(&bar[XB_XCNT(b.x)], 1u);
    return b;
}
__device__ __forceinline__ void xcd_barrier_complete(unsigned* bar, unsigned x, unsigned& nloc, unsigned& nx) {
    const unsigned G = gridDim.x * gridDim.y * gridDim.z;
    unsigned sum, cnt, mine, sp = 0u;
    for (;;) {
        sum = 0u; cnt = 0u; mine = 0u;
#pragma unroll
        for (unsigned j = 0; j < 16; ++j) { const unsigned c = xb_ld(&bar[XB_XCNT(j)]); sum += c; cnt += (c > 0u) ? 1u : 0u; mine = (j == x) ? c : mine; }
        if (sum == G) break;
        __builtin_amdgcn_s_sleep(1);
        if ((++sp & 255u) == 0u) { if (xb_ld(&bar[XB_TMO])) break; if (sp > XB_SPIN_CAP) { atomicAdd(&bar[XB_TMO], 1u); break; } }
    }
    nloc = mine > 0u ? mine : 1u; nx = cnt > 0u ? cnt : 1u;
}

__device__ __forceinline__ void xcd_barrier(const XcdBarrier& b) {
    asm volatile("s_waitcnt vmcnt(0)" ::: "memory");
    __syncthreads();
    if (threadIdx.x == 0) {
        unsigned* bar = b.bar;
        __builtin_amdgcn_s_waitcnt(0);
        unsigned nloc = b.st[0], nx = b.st[1];
        if (nloc == 0u) { xcd_barrier_complete(bar, b.x, nloc, nx); b.st[0] = nloc; b.st[1] = nx; }
        const unsigned old = xb_add(&bar[XB_XSUB(b.x)], 1u);
        const unsigned gen = old / nloc;
        if (old + 1u == (gen + 1u) * nloc) {
            __builtin_amdgcn_fence(__ATOMIC_RELEASE, "agent");
            asm volatile("s_waitcnt vmcnt(0)" ::: "memory");
            const unsigned og = xb_add(&bar[XB_TOP], 1u);
            const unsigned tg = og / nx;
            if (og + 1u == (tg + 1u) * nx) xb_add(&bar[XB_TOPGEN], 1u);
            else XB_SPIN(xb_ld(&bar[XB_TOPGEN]) == tg, bar);
            __builtin_amdgcn_fence(__ATOMIC_ACQUIRE, "agent");
            xb_add(&bar[XB_XGEN(b.x)], 1u);
            asm volatile("s_waitcnt vmcnt(0)" ::: "memory");
        } else {
            XB_SPIN(xb_ld(&bar[XB_XGEN(b.x)]) == gen, bar);
            __builtin_amdgcn_fence(__ATOMIC_ACQUIRE, "agent");
            asm volatile("s_waitcnt vmcnt(0)" ::: "memory");
        }
    }
    __syncthreads();
}

struct Frame {
    LAS unsigned char* lds;
    int tid, lane, wave, G, bid;
    float* out; unsigned char* ws;
};
__device__ __forceinline__ const float* inp(int i) {
    const __attribute__((address_space(4))) char* k = (const __attribute__((address_space(4))) char*)__builtin_amdgcn_kernarg_segment_ptr();
    asm volatile("" : "+s"(k));
    return *(const float* const __attribute__((address_space(4)))*)(k + 8 * i);
}
enum { I_X = 0, I_MEM, I_GMIX, I_WIN, I_RELB, I_CONVW, I_CONVB, I_WRG, I_BRG, I_WIG, I_BIG, I_LRUL, I_GOA, I_GOL, I_WOUT, I_GCROSS, I_GMEM, I_WQC, I_WKC, I_WVC, I_WOC,
       I_GFFN, I_WGATE, I_WUP, I_WDOWN, I_GFINAL };

struct OneUnit {
    int pm, pn;
    __device__ __forceinline__ bool next(int i, pg8::Unit& u) const { if (i != 0) return false; u.pm = pm; u.pn = pn; return true; }
    __device__ __forceinline__ void a_ready(const pg8::Unit&) const {}
    __device__ __forceinline__ void done(const pg8::Unit&) const {}
};
constexpr int NMEMCU = 32;
__device__ __forceinline__ void p0_tr(const float* W, int ldw, int k0, int n0, bf16* dst, int ldd, const float* gk, LAS float* scr, int lane) {
    const float* wp = W + (size_t)k0 * ldw + n0 + lane;
    float v[64];
#pragma unroll
    for (int kk = 0; kk < 64; ++kk) v[kk] = __builtin_nontemporal_load(wp + (size_t)kk * ldw);
    if (gk) {
#pragma unroll
        for (int kk = 0; kk < 64; ++kk) v[kk] *= gk[k0 + kk]; }
#pragma unroll
    for (int kk = 0; kk < 64; ++kk) scr[kk * 65 + lane] = v[kk];
    asm volatile("s_waitcnt lgkmcnt(0)" ::: "memory");
    const int c = lane & 7;
#pragma unroll
    for (int j = 0; j < 8; ++j) { const int n = (lane >> 3) + 8 * j; const LAS float* s = scr + (8 * c) * 65 + n;
        v4u o; o.x = pk2(s[0 * 65], s[1 * 65]); o.y = pk2(s[2 * 65], s[3 * 65]); o.z = pk2(s[4 * 65], s[5 * 65]); o.w = pk2(s[6 * 65], s[7 * 65]);
        *(v4u*)(dst + (size_t)n * ldd + k0 + 8 * c) = o; }
    asm volatile("s_waitcnt lgkmcnt(0)" ::: "memory");
}
__device__ __forceinline__ void rms_row_bf16(const float* xrow, const float* g, bf16* orow, int lane) {
    const f32x4* xr = (const f32x4*)xrow + lane; const f32x4* gr = (const f32x4*)g + lane;
    f32x4 v[4]; float s = 0.f;
#pragma unroll
    for (int j = 0; j < 4; ++j) { v[j] = xr[64 * j]; s += (v[j].x * v[j].x + v[j].y * v[j].y) + (v[j].z * v[j].z + v[j].w * v[j].w); }
    const float rs = 1.f / sqrtf(wave_sum(s) * (1.f / DM) + EPS);
    v2u* o8 = (v2u*)orow + lane;
#pragma unroll
    for (int j = 0; j < 4; ++j) { const f32x4 gg = gr[64 * j]; v2u w; w.x = pk2(v[j].x * rs * gg.x, v[j].y * rs * gg.y); w.y = pk2(v[j].z * rs * gg.z, v[j].w * rs * gg.w); o8[64 * j] = w; }
}
__device__ __forceinline__ void p0_prologue(Frame& F) {
    LAS float* scr = (LAS float*)(F.lds + F.wave * 16640);
    const int lane = F.lane;
    unsigned char* ws = F.ws;
    const bool memcu = F.G == 256 && F.bid >= 256 - NMEMCU;
    if (memcu) {
        const int mw = (F.bid - (256 - NMEMCU)) * 8 + F.wave;
        for (int q = mw; q < 512; q += NMEMCU * 8) { const int which = q >> 8, r = q & 255, kb = r / 16, nb = r % 16;
            p0_tr(which ? inp(I_WVC) : inp(I_WKC), DM, 64 * kb, 64 * nb, (bf16*)(ws + (which ? WS_WVC : WS_WK)) + (size_t)(64 * nb) * DM, DM, nullptr, scr, lane); }
        for (int m = mw; m < NB * NMEM; m += NMEMCU * 8) rms_row_bf16(inp(I_MEM) + (size_t)m * DM, inp(I_GMEM), (bf16*)(ws + WS_MN) + (size_t)m * DM, lane);
        asm volatile("s_waitcnt vmcnt(0)" ::: "memory"); __syncthreads();
        if (F.tid == 0) { unsigned* c = (unsigned*)(ws + 57344);
            __builtin_amdgcn_fence(__ATOMIC_RELEASE, "agent"); asm volatile("s_waitcnt vmcnt(0)" ::: "memory");
            __hip_atomic_fetch_add(c, 1u, __ATOMIC_RELAXED, __HIP_MEMORY_SCOPE_AGENT);
            unsigned sp = 0; while (__hip_atomic_load(c, __ATOMIC_RELAXED, __HIP_MEMORY_SCOPE_AGENT) < (unsigned)NMEMCU) { __builtin_amdgcn_s_sleep(2); if (++sp > (1u << 22)) break; }
            __builtin_amdgcn_fence(__ATOMIC_ACQUIRE, "agent"); asm volatile("s_waitcnt vmcnt(0)" ::: "memory"); }
        __syncthreads();
        const int j = F.bid - (256 - NMEMCU);
        if (j < 16) { pg8::Gemm g{(const pg8::bf16_t*)(ws + WS_MN), (const pg8::bf16_t*)(ws + WS_WK), NB * NMEM, DM, DM}; OneUnit S{j >> 2, j & 3};
            pg8::EpiBf E{(pg8::bf16_t*)(ws + WS_KX), DM, nullptr, 0, 1.0f, false}; pg8::gemm_phase<pg8::EpiBf, OneUnit, true, true>(F.lds, g, S, E); }
        else { pg8::Gemm g{(const pg8::bf16_t*)(ws + WS_WVC), (const pg8::bf16_t*)(ws + WS_MN), DM, NB * NMEM, DM}; OneUnit S{(j - 16) >> 2, (j - 16) & 3};
            pg8::EpiBf E{(pg8::bf16_t*)(ws + WS_VXT), NB * NMEM, nullptr, 0, 1.0f, true}; pg8::gemm_phase<pg8::EpiBf, OneUnit, true, true>(F.lds, g, S, E); }
    }
    const int NNORM = memcu || F.G != 256 ? (F.G == 256 ? (256 - NMEMCU) * 8 : F.G * 8) : (256 - NMEMCU) * 8;
    const int NSH = F.G == 256 ? 4 * NNORM + NMEMCU * 8 : NNORM;
    const int nsh = F.G == 256 ? (memcu ? 1 : 4) : 1;
    constexpr int I_IN = 16 * 40, I_SQ = 16 * 16, I_GU = 16 * 44, I_DN = 44 * 16, I_LR = 8;
    constexpr int NITEMS = I_IN + 3 * I_SQ + 2 * I_GU + I_DN + 2 * I_LR;
    for (int sh = 0; sh < nsh; ++sh) {
      const int q0 = F.G != 256 ? F.bid * 8 + F.wave : memcu ? 4 * NNORM + (F.bid - (256 - NMEMCU)) * 8 + F.wave : sh * NNORM + F.bid * 8 + F.wave;
      for (int it = q0; it < NITEMS; it += NSH) {
        int r = it;
        if (r < I_IN) { const int kb = r / 40, nb = r % 40, n0 = 64 * nb, seg = n0 >> 9, within = n0 & 511;
            bf16* dst = (seg == 2) ? (bf16*)(ws + WS_WV) + (size_t)within * DM : (bf16*)(ws + WS_WA) + (size_t)((seg < 2 ? seg : seg - 1) * 512 + within) * DM;
            p0_tr(inp(I_WIN), 2560, 64 * kb, n0, dst, DM, inp(I_GMIX), scr, lane); continue; } r -= I_IN;
        if (r < 3 * I_SQ) { const int which = r / I_SQ, q = r % I_SQ, kb = q / 16, nb = q % 16;
            const float* W = which == 0 ? inp(I_WOUT) : which == 1 ? inp(I_WQC) : inp(I_WOC);
            const size_t off = which == 0 ? WS_WOUT : which == 1 ? WS_WQ : WS_WO;
            p0_tr(W, DM, 64 * kb, 64 * nb, (bf16*)(ws + off) + (size_t)(64 * nb) * DM, DM, which == 1 ? inp(I_GCROSS) : nullptr, scr, lane); continue; } r -= 3 * I_SQ;
        if (r < 2 * I_GU) { const int which = r / I_GU, q = r % I_GU, kb = q / 44, nb = q % 44, n0 = 64 * nb;
            const int drow = 256 * (n0 >> 7) + 128 * which + (n0 & 127);
            p0_tr(which ? inp(I_WUP) : inp(I_WGATE), DFF, 64 * kb, n0, (bf16*)(ws + WS_WGU) + (size_t)drow * DM, DM, inp(I_GFFN), scr, lane); continue; } r -= 2 * I_GU;
        if (r < I_DN) { const int kb = r / 16, nb = r % 16;
            p0_tr(inp(I_WDOWN), DM, 64 * kb, 64 * nb, (bf16*)(ws + WS_WDN) + (size_t)(64 * nb) * DFF, DFF, nullptr, scr, lane); continue; } r -= I_DN;
        { const int which = r / I_LR, blk = r % I_LR;
            p0_tr((which ? inp(I_WIG) : inp(I_WRG)) + blk * 4096, 64, 0, 0, (bf16*)(ws + (which ? WS_WIG : WS_WRG)) + blk * 4096, 64, nullptr, scr, lane); }
      }
      {
        const float* X = inp(I_X); bf16* XN = (bf16*)(ws + WS_XN); float* RS0 = (float*)(ws + WS_RS0);
        for (int m0 = q0 * 4; m0 < T; m0 += NSH * 4) {
            f32x4 v[4][4];
#pragma unroll
            for (int r = 0; r < 4; ++r)
#pragma unroll
                for (int j = 0; j < 4; ++j) v[r][j] = __builtin_nontemporal_load((const f32x4*)(X + (size_t)(m0 + r) * DM) + lane + 64 * j);
#pragma unroll
            for (int r = 0; r < 4; ++r) { float sq = 0.f;
#pragma unroll
                for (int j = 0; j < 4; ++j) sq += (v[r][j].x * v[r][j].x + v[r][j].y * v[r][j].y) + (v[r][j].z * v[r][j].z + v[r][j].w * v[r][j].w);
                const float rs = 1.f / sqrtf(wave_sum(sq) * (1.f / DM) + EPS);
                v2u* o8 = (v2u*)(XN + (size_t)(m0 + r) * DM) + lane;
#pragma unroll
                for (int j = 0; j < 4; ++j) { v2u wv; wv.x = pk2(v[r][j].x, v[r][j].y); wv.y = pk2(v[r][j].z, v[r][j].w); o8[64 * j] = wv; }
                if (lane == 0) RS0[m0 + r] = rs; }
        }
    }
    }
}

constexpr int ATT_BT_OFF = 65536;
__device__ __forceinline__ void attn_phase(Frame& F) {
    if (F.G != 256) return;
    const int lane = F.lane, w = F.wave, tid = F.tid, q32 = lane & 31, hi = lane >> 5;
    const bf16* PA = (const bf16*)(F.ws + WS_PA); const bf16* VT = (const bf16*)(F.ws + WS_VT);
    LAS float* btw = (LAS float*)(F.lds + ATT_BT_OFF);
    const int h = (F.bid >> 5) & 7, cb = F.bid & 31;
    const int c0 = 4 * cb, cq = c0 + (w >> 1), qoff = 32 * (w & 1) + q32;
    if (tid < 257) { const float* rb = inp(I_RELB) + h * 257; btw[tid] = (rb[tid] - rb[256]) * LOG2E; }
    const int kc_lo = c0 >= 8 ? c0 - 8 : 0, nstep = (c0 + 4 - kc_lo) >> 1;
    const int prow = 8 * w + (lane >> 3), plc = (lane & 7) ^ ((prow >> 1) & 7);
    const bf16* ksrc = PA + (size_t)prow * PAW + 512 + h * 64 + 8 * plc;
    const bf16* vsrc = VT + (size_t)(h * 64 + prow) * T + 8 * plc;
#define ATT_DMA(b_, kc_, slot_) do { const size_t tk_ = (size_t)(b_) * SEQ + (size_t)(kc_) * 64; \
        __builtin_amdgcn_global_load_lds((const unsigned*)(ksrc + tk_ * PAW), (LAS unsigned*)(F.lds + (slot_) * 16384 + w * 1024), 16, 0, 0); \
        __builtin_amdgcn_global_load_lds((const unsigned*)(vsrc + tk_), (LAS unsigned*)(F.lds + (slot_) * 16384 + 8192 + w * 1024), 16, 0, 0); } while (0)
#define ATT_LDQ(Q, b_) do { const bf16* qp_ = PA + ((size_t)(b_) * SEQ + (size_t)cq * 64 + qoff) * PAW + h * 64 + 8 * hi; \
        _Pragma("unroll") for (int ks = 0; ks < 4; ++ks) Q[ks] = *(const bf16x8*)(qp_ + 16 * ks); } while (0)
    bf16x8 qf[4], qn[4];
    ATT_LDQ(qf, 0);
    ATT_DMA(0, kc_lo, 0); ATT_DMA(0, kc_lo + 1, 1);
    const int sw = (q32 >> 1) & 7;
    int g = 0;
#pragma unroll 1
    for (int b = 0; b < NB; ++b) {
        f32x16 oA[2], oB[2];
#pragma unroll
        for (int dt = 0; dt < 2; ++dt)
#pragma unroll
            for (int r = 0; r < 16; ++r) { oA[dt][r] = 0.f; oB[dt][r] = 0.f; }
        float mref = 0.f; f32x2_t lsum = {0.f, 0.f}; bool first = true;
        f32x16 negm;
#pragma unroll
        for (int r = 0; r < 16; ++r) negm[r] = 0.f;
#pragma unroll 1
        for (int j = 0; j < nstep; ++j, ++g) {
            const int kc0 = kc_lo + 2 * j;
            if (b > 0 && j == 0) asm volatile("s_waitcnt vmcnt(9) lgkmcnt(0)" ::: "memory");
            else asm volatile("s_waitcnt vmcnt(0) lgkmcnt(0)" ::: "memory");
            __builtin_amdgcn_s_barrier();
            asm volatile("" ::: "memory");
            {
                const int sl = ((g + 1) & 1) * 2;
                if (j + 1 < nstep) { ATT_DMA(b, kc0 + 2, sl); ATT_DMA(b, kc0 + 3, sl + 1); }
                else if (b + 1 < NB) { ATT_DMA(b + 1, kc_lo, sl); ATT_DMA(b + 1, kc_lo + 1, sl + 1); ATT_LDQ(qn, b + 1); }
            }
            const int d0 = cq - kc0, d1 = d0 - 1;
            const bool a0 = d0 >= 0 && d0 <= 8, a1 = d1 >= 0 && d1 <= 8;
            if (a0 || a1) {
                const LAS unsigned char* t0 = F.lds + ((g & 1) * 2) * 16384; const LAS unsigned char* t1 = t0 + 16384;
                f32x16 s00 = negm, s01 = negm, s10 = negm, s11 = negm;
                if (!a0) {
#pragma unroll
                    for (int r = 0; r < 16; ++r) { s00[r] = -1e30f; s01[r] = -1e30f; } }
                if (!a1) {
#pragma unroll
                    for (int r = 0; r < 16; ++r) { s10[r] = -1e30f; s11[r] = -1e30f; } }
                if (a0 && d0 <= 2) {
                    const int relb = d0 * 64 + qoff - 4 * hi;
#pragma unroll
                    for (int r = 0; r < 16; ++r) { const int kk = (r & 3) + 8 * (r >> 2); int e0 = relb - kk, e1 = relb - 32 - kk; e0 = e0 > 128 ? 128 : e0; e1 = e1 > 128 ? 128 : e1;
                        s00[r] += btw[e0 + 128]; s01[r] += btw[e1 + 128]; } }
                if (a1 && d1 <= 2) {
                    const int relb = d1 * 64 + qoff - 4 * hi;
#pragma unroll
                    for (int r = 0; r < 16; ++r) { const int kk = (r & 3) + 8 * (r >> 2); int e0 = relb - kk, e1 = relb - 32 - kk; e0 = e0 > 128 ? 128 : e0; e1 = e1 > 128 ? 128 : e1;
                        s10[r] += btw[e0 + 128]; s11[r] += btw[e1 + 128]; } }
#pragma unroll
                for (int ks = 0; ks < 4; ++ks) { const int co = ((2 * ks + hi) ^ sw) << 4;
                    const bf16x8 k00 = *(const LAS bf16x8*)(t0 + q32 * 128 + co), k01 = *(const LAS bf16x8*)(t0 + (q32 + 32) * 128 + co);
                    const bf16x8 k10 = *(const LAS bf16x8*)(t1 + q32 * 128 + co), k11 = *(const LAS bf16x8*)(t1 + (q32 + 32) * 128 + co);
                    s00 = MFMA32(k00, qf[ks], s00); s01 = MFMA32(k01, qf[ks], s01); s10 = MFMA32(k10, qf[ks], s10); s11 = MFMA32(k11, qf[ks], s11); }
                float tm0 = fmaxf(s00[0], s01[0]), tm1 = fmaxf(s10[0], s11[0]);
#pragma unroll
                for (int r = 1; r < 16; ++r) { tm0 = fmaxf(fmaxf(tm0, s00[r]), s01[r]); tm1 = fmaxf(fmaxf(tm1, s10[r]), s11[r]); }
                float tmax = fmaxf(tm0, tm1);
                tmax = fmaxf(tmax, xor32_get(tmax));
                if (first || __any(tmax > 16.0f)) {
                    const float delta = first ? tmax : fmaxf(tmax, 0.f);
                    if (!first) { const float f = __builtin_amdgcn_exp2f(-delta); lsum *= f;
#pragma unroll
                        for (int dt = 0; dt < 2; ++dt)
#pragma unroll
                            for (int r = 0; r < 16; ++r) { oA[dt][r] *= f; oB[dt][r] *= f; } }
                    mref += delta; first = false;
#pragma unroll
                    for (int r = 0; r < 16; ++r) { s00[r] -= delta; s01[r] -= delta; s10[r] -= delta; s11[r] -= delta; negm[r] = -mref; }
                }
                float sv[64];
#pragma unroll
                for (int r = 0; r < 16; ++r) { sv[r] = __builtin_amdgcn_exp2f(s00[r]); sv[16 + r] = __builtin_amdgcn_exp2f(s01[r]); sv[32 + r] = __builtin_amdgcn_exp2f(s10[r]); sv[48 + r] = __builtin_amdgcn_exp2f(s11[r]); }
#pragma unroll
                for (int r = 0; r < 64; r += 2) lsum += (f32x2_t){sv[r], sv[r + 1]};
                bf16x8 pf[8];
#pragma unroll
                for (int k8 = 0; k8 < 8; ++k8) pf[k8] = pack8(sv + 8 * k8);
#pragma unroll
                for (int dt = 0; dt < 2; ++dt)
#pragma unroll
                    for (int k4 = 0; k4 < 4; ++k4) { const int vo = 8192 + (32 * dt + q32) * 128 + (((2 * k4 + hi) ^ sw) << 4);
                        const bf16x8 v0 = *(const LAS bf16x8*)(t0 + vo), v1 = *(const LAS bf16x8*)(t1 + vo);
                        oA[dt] = MFMA32(v0, pf[k4], oA[dt]); oB[dt] = MFMA32(v1, pf[4 + k4], oB[dt]); }
            }
        }
        const float lrun = lsum.x + lsum.y;
        const float lt = lrun + xor32_get(lrun), inv = 1.0f / lt; float q = 0.f;
        const size_t qrow = (size_t)b * SEQ + (size_t)cq * 64 + qoff;
        bf16* orow = (bf16*)(F.ws + WS_ATT) + qrow * 512 + h * 64;
#pragma unroll
        for (int dt = 0; dt < 2; ++dt)
#pragma unroll
            for (int jj = 0; jj < 4; ++jj) { const float v0 = (oA[dt][4 * jj] + oB[dt][4 * jj]) * inv, v1 = (oA[dt][4 * jj + 1] + oB[dt][4 * jj + 1]) * inv, v2 = (oA[dt][4 * jj + 2] + oB[dt][4 * jj + 2]) * inv, v3 = (oA[dt][4 * jj + 3] + oB[dt][4 * jj + 3]) * inv;
                q += (v0 * v0 + v1 * v1) + (v2 * v2 + v3 * v3);
                v2u wv; wv.x = pk2(v0, v1); wv.y = pk2(v2, v3); *(v2u*)(orow + 32 * dt + 8 * jj + 4 * hi) = wv; }
        q += xor32_get(q);
        if (hi == 0) ((float*)(F.ws + WS_ASS))[qrow * 8 + h] = q;
#pragma unroll
        for (int ks = 0; ks < 4; ++ks) qf[ks] = qn[ks];
    }
#undef ATT_DMA
#undef ATT_LDQ
    asm volatile("s_waitcnt vmcnt(0) lgkmcnt(0)" ::: "memory");
    __builtin_amdgcn_s_barrier();
    asm volatile("" ::: "memory");
}

__device__ __forceinline__ void lru1_item(Frame& F, int b, int c) {
    const int lane = F.lane, w = F.wave, q32 = lane & 31, hi = lane >> 5;
    LAS float* U = (LAS float*)(F.lds + w * 17408);
    bf16x8 wrf[2][4], wif[2][4]; float brg2[2], big2[2], sp82[2];
    { const bf16* WRG0 = (const bf16*)(F.ws + WS_WRG) + w * 4096; const bf16* WIG0 = (const bf16*)(F.ws + WS_WIG) + w * 4096;
#pragma unroll
      for (int dt = 0; dt < 2; ++dt) { const int dl = 32 * dt + q32, ch = w * 64 + dl;
#pragma unroll
          for (int ks = 0; ks < 4; ++ks) { wrf[dt][ks] = *(const bf16x8*)(WRG0 + dl * 64 + 16 * ks + 8 * hi); wif[dt][ks] = *(const bf16x8*)(WIG0 + dl * 64 + 16 * ks + 8 * hi); }
          brg2[dt] = inp(I_BRG)[ch]; big2[dt] = inp(I_BIG)[ch]; sp82[dt] = inp(I_LRUL)[ch]; } }
    const bf16* PA = (const bf16*)(F.ws + WS_PA);
    const size_t rowbase = (size_t)b * SEQ + (size_t)c * 64;
    {
        const int ch = w * 64 + lane; const float* cw = inp(I_CONVW);
        const float w0 = cw[ch], w1 = cw[512 + ch], w2 = cw[1024 + ch], w3 = cw[1536 + ch], cb = inp(I_CONVB)[ch];
        const bf16* xp = PA + 1024 + ch;
        float x0 = 0.f, x1 = 0.f, x2 = 0.f;
        if (c > 0) { x0 = bf2f(xp[(rowbase - 3) * PAW]); x1 = bf2f(xp[(rowbase - 2) * PAW]); x2 = bf2f(xp[(rowbase - 1) * PAW]); }
#pragma unroll 16
        for (int t = 0; t < 64; ++t) { const float x3 = bf2f(xp[(rowbase + t) * PAW]); U[t * 68 + lane] = ((w0 * x0 + w1 * x1) + (w2 * x2 + w3 * x3)) + cb; x0 = x1; x1 = x2; x2 = x3; }
    }
    asm volatile("s_waitcnt lgkmcnt(0)" ::: "memory");
    bf16x8 uf[2][4];
#pragma unroll
    for (int tt = 0; tt < 2; ++tt)
#pragma unroll
        for (int ks = 0; ks < 4; ++ks) { const LAS f32x4* p = (const LAS f32x4*)(U + (32 * tt + q32) * 68 + 16 * ks + 8 * hi); const f32x4 a = p[0], bq = p[1];
            float tmp[8] = {a[0], a[1], a[2], a[3], bq[0], bq[1], bq[2], bq[3]}; uf[tt][ks] = pack8(tmp); }
    unsigned* HA = (unsigned*)(F.ws + WS_HLOC); float* LP = (float*)(F.ws + WS_LP); float* LH = (float*)(F.ws + WS_LH);
#pragma unroll
    for (int dt = 0; dt < 2; ++dt) {
        const int dl = 32 * dt + q32, ch = w * 64 + dl;
        const float brg = brg2[dt], big = big2[dt];
        const float sp8 = -8.0f * LOG2E * log1pf(expf(-sp82[dt]));
        float av[2][16], hv[2][16];
#pragma unroll
        for (int tt = 0; tt < 2; ++tt) {
            f32x16 R, I;
#pragma unroll
            for (int r = 0; r < 16; ++r) { R[r] = 0.f; I[r] = 0.f; }
#pragma unroll
            for (int ks = 0; ks < 4; ++ks) { R = MFMA32(uf[tt][ks], wrf[dt][ks], R); I = MFMA32(uf[tt][ks], wif[dt][ks], I); }
#pragma unroll
            for (int r = 0; r < 16; ++r) {
                const float rg = __builtin_amdgcn_rcpf(1.0f + __builtin_amdgcn_exp2f(-LOG2E * (R[r] + brg))), ig = __builtin_amdgcn_rcpf(1.0f + __builtin_amdgcn_exp2f(-LOG2E * (I[r] + big)));
                const float a = __builtin_amdgcn_exp2f(sp8 * rg), mult = __builtin_amdgcn_sqrtf(fmaxf(1.0f - a * a, 0.0f));
                const float uval = U[(32 * tt + crow(r, hi)) * 68 + dl];
                av[tt][r] = a; hv[tt][r] = mult * ig * uval;
            }
#pragma unroll
            for (int j = 0; j < 4; ++j)
#pragma unroll
                for (int e = 1; e < 4; ++e) { hv[tt][4 * j + e] = av[tt][4 * j + e] * hv[tt][4 * j + e - 1] + hv[tt][4 * j + e]; av[tt][4 * j + e] = av[tt][4 * j + e] * av[tt][4 * j + e - 1]; }
        }
        float cA = 1.0f, cH = 0.0f;
#pragma unroll
        for (int k = 0; k < 8; ++k) {
            const int tt = k >> 2, j = k & 3; const float Ag = av[tt][4 * j + 3], Hg = hv[tt][4 * j + 3];
            const float nA = Ag * cA, nH = Ag * cH + Hg;
            const float oA = xor32_get(nA), oH = xor32_get(nH);
            const float eA = hi == 0 ? nA : oA, eH = hi == 0 ? nH : oH;
            const float fA = hi == 0 ? cA : eA, fH = hi == 0 ? cH : eH;
            const float n2A = Ag * eA, n2H = Ag * eH + Hg;
            const float o2A = xor32_get(n2A), o2H = xor32_get(n2H);
            cA = hi == 1 ? n2A : o2A; cH = hi == 1 ? n2H : o2H;
#pragma unroll
            for (int e = 0; e < 4; ++e) { hv[tt][4 * j + e] = av[tt][4 * j + e] * fH + hv[tt][4 * j + e]; av[tt][4 * j + e] = av[tt][4 * j + e] * fA; }
        }
#pragma unroll
        for (int tt = 0; tt < 2; ++tt)
#pragma unroll
            for (int r = 0; r < 16; ++r) U[(32 * tt + crow(r, hi)) * 68 + dl] = __builtin_bit_cast(float, pk2(hv[tt][r], av[tt][r]));
        if (hi == 1) { const size_t off = (size_t)(b * NCH + c) * DLRU + ch; LP[off] = av[1][15]; LH[off] = hv[1][15]; }
    }
    asm volatile("s_waitcnt lgkmcnt(0)" ::: "memory");
#pragma unroll 4
    for (int j = 0; j < 16; ++j) { const int t = 4 * j + (lane >> 4), c4 = lane & 15;
        const f32x4 v = *(const LAS f32x4*)(U + t * 68 + 4 * c4);
        *(f32x4*)(HA + (rowbase + t) * DLRU + w * 64 + 4 * c4) = v; }
    asm volatile("s_waitcnt lgkmcnt(0)" ::: "memory");
}

__device__ __forceinline__ float gelu_tanh(float x) {
    const float y = fminf(fmaxf(0.7978845608028654f * (x + 0.044715f * x * x * x), -15.0f), 15.0f);
    const float e = __builtin_amdgcn_exp2f(-2.0f * LOG2E * y);
    const float th = (1.0f - e) * __builtin_amdgcn_rcpf(1.0f + e);
    return 0.5f * x * (1.0f + th);
}
__device__ __forceinline__ void lru3_item(Frame& F, int b, int c) {
    const int lane = F.lane, w = F.wave;
    const unsigned* HA = (const unsigned*)(F.ws + WS_HLOC);
    const float* LP = (const float*)(F.ws + WS_LP); const float* LH = (const float*)(F.ws + WS_LH);
    const bf16* PA = (const bf16*)(F.ws + WS_PA); bf16* MG = (bf16*)(F.ws + WS_MERGED);
    const bf16* ATT = (const bf16*)(F.ws + WS_ATT); const float* ASS = (const float*)(F.ws + WS_ASS);
    LAS f32x4* SA = (LAS f32x4*)F.lds; LAS f32x4* SH = (LAS f32x4*)(F.lds + 16384);
    float cH[8];
    {
        const int per = (c + 7) >> 3, j0 = w * per, j1 = (j0 + per) < c ? (j0 + per) : c;
        float A[8], H[8];
#pragma unroll
        for (int e = 0; e < 8; ++e) { A[e] = 1.f; H[e] = 0.f; }
#pragma unroll 4
        for (int j = j0; j < j1; ++j) { const size_t off = (size_t)(b * NCH + j) * DLRU + 8 * lane;
            const f32x4 p0 = *(const f32x4*)(LP + off), p1 = *(const f32x4*)(LP + off + 4), h0 = *(const f32x4*)(LH + off), h1 = *(const f32x4*)(LH + off + 4);
#pragma unroll
            for (int e = 0; e < 4; ++e) { H[e] = p0[e] * H[e] + h0[e]; A[e] *= p0[e]; H[4 + e] = p1[e] * H[4 + e] + h1[e]; A[4 + e] *= p1[e]; } }
        SA[w * 128 + 2 * lane] = (f32x4){A[0], A[1], A[2], A[3]}; SA[w * 128 + 2 * lane + 1] = (f32x4){A[4], A[5], A[6], A[7]};
        SH[w * 128 + 2 * lane] = (f32x4){H[0], H[1], H[2], H[3]}; SH[w * 128 + 2 * lane + 1] = (f32x4){H[4], H[5], H[6], H[7]};
        __syncthreads();
#pragma unroll
        for (int e = 0; e < 8; ++e) cH[e] = 0.f;
#pragma unroll
        for (int sg = 0; sg < 8; ++sg) { const f32x4 a0 = SA[sg * 128 + 2 * lane], a1 = SA[sg * 128 + 2 * lane + 1], h0 = SH[sg * 128 + 2 * lane], h1 = SH[sg * 128 + 2 * lane + 1];
#pragma unroll
            for (int e = 0; e < 4; ++e) { cH[e] = a0[e] * cH[e] + h0[e]; cH[4 + e] = a1[e] * cH[4 + e] + h1[e]; } }
    }
    const f32x4 g0 = *(const f32x4*)(inp(I_GOL) + 8 * lane), g1 = *(const f32x4*)(inp(I_GOL) + 8 * lane + 4);
    const f32x4 ga0 = *(const f32x4*)(inp(I_GOA) + 8 * lane), ga1 = *(const f32x4*)(inp(I_GOA) + 8 * lane + 4);
#pragma unroll 1
    for (int tb = 0; tb < 8; tb += 4) {
        v4u hl[4], ac[4]; f32x4 as_[4][2]; v4u gu[4], av[4];
#pragma unroll
        for (int r = 0; r < 4; ++r) { const size_t row = (size_t)b * SEQ + (size_t)c * 64 + 8 * w + tb + r, off = row * DLRU + 8 * lane;
            hl[r] = *(const v4u*)(HA + off); ac[r] = *(const v4u*)(HA + off + 4);
            gu[r] = *(const v4u*)(PA + row * PAW + 1536 + 8 * lane); av[r] = *(const v4u*)(ATT + row * 512 + 8 * lane);
            as_[r][0] = *(const f32x4*)(ASS + row * 8); as_[r][1] = *(const f32x4*)(ASS + row * 8 + 4); }
#pragma unroll
        for (int r = 0; r < 4; ++r) { const size_t row = (size_t)b * SEQ + (size_t)c * 64 + 8 * w + tb + r;
            float rec[8]; float q = 0.f;
#pragma unroll
            for (int e = 0; e < 8; ++e) { const unsigned pw = e < 4 ? hl[r][e & 3] : ac[r][e & 3];
                const float hv = __builtin_bit_cast(float, pw << 16), a = __builtin_bit_cast(float, pw & 0xffff0000u);
                const unsigned wv = gu[r][e >> 1]; const float gv = (e & 1) ? __builtin_bit_cast(float, wv & 0xffff0000u) : __builtin_bit_cast(float, wv << 16);
                rec[e] = (hv + a * cH[e]) * gelu_tanh(gv); q += rec[e] * rec[e]; }
            const float rs = 1.0f / sqrtf(wave_sum(q) * (1.0f / 512.0f) + EPS);
            v4u o; o.x = pk2(rec[0] * rs * g0[0], rec[1] * rs * g0[1]); o.y = pk2(rec[2] * rs * g0[2], rec[3] * rs * g0[3]);
            o.z = pk2(rec[4] * rs * g1[0], rec[5] * rs * g1[1]); o.w = pk2(rec[6] * rs * g1[2], rec[7] * rs * g1[3]);
            *(v4u*)(MG + row * DM + 512 + 8 * lane) = o;
            const f32x4 s0 = as_[r][0], s1 = as_[r][1];
            const float rsa = 1.0f / sqrtf((((s0[0] + s0[1]) + (s0[2] + s0[3])) + ((s1[0] + s1[1]) + (s1[2] + s1[3]))) * (1.0f / 512.0f) + EPS);
            float a[8];
#pragma unroll
            for (int e = 0; e < 8; ++e) { const unsigned wv = av[r][e >> 1]; a[e] = ((e & 1) ? __builtin_bit_cast(float, wv & 0xffff0000u) : __builtin_bit_cast(float, wv << 16)) * rsa; }
            v4u oa; oa.x = pk2(a[0] * ga0[0], a[1] * ga0[1]); oa.y = pk2(a[2] * ga0[2], a[3] * ga0[3]); oa.z = pk2(a[4] * ga1[0], a[5] * ga1[1]); oa.w = pk2(a[6] * ga1[2], a[7] * ga1[3]);
            *(v4u*)(MG + row * DM + 8 * lane) = oa;
        }
    }
    __syncthreads();
}

__device__ __forceinline__ void xattn_phase(Frame& F, const pg8::StaticOrder& S) {
    const int lane = F.lane, w = F.wave, q32 = lane & 31, hi = lane >> 5;
    LAS unsigned char* L = F.lds;
    const bf16* QX = (const bf16*)(F.ws + WS_QX); const bf16* KX = (const bf16*)(F.ws + WS_KX); const bf16* VXT = (const bf16*)(F.ws + WS_VXT); bf16* OX = (bf16*)(F.ws + WS_OX);
#define XID(u_) (((((u_).pm >> 5) * 4 + (u_).pn) << 5) | ((u_).pm & 31))
#define XA_DMA_K(it_, qd_, slot_) do { const int bh_ = (it_) >> 5, b_ = bh_ >> 2, h_ = bh_ & 3; \
        _Pragma("unroll") for (int j = 0; j < 4; ++j) { const int row_ = 8 * (4 * w + j) + (lane >> 3), lc_ = (lane & 7) ^ ((row_ >> 1) & 7); \
            __builtin_amdgcn_global_load_lds((const unsigned*)(KX + (size_t)(b_ * NMEM + row_) * DM + h_ * 256 + 64 * (qd_) + 8 * lc_), (LAS unsigned*)(L + (slot_) * 32768 + (4 * w + j) * 1024), 16, 0, 0); } } while (0)
#define XA_DMA_V(it_, qd_, slot_) do { const int bh_ = (it_) >> 5, b_ = bh_ >> 2, h_ = bh_ & 3; \
        _Pragma("unroll") for (int j = 0; j < 4; ++j) { const int row_ = 2 * (4 * w + j) + (lane >> 5), lc_ = (lane & 31) ^ (row_ & 31); \
            __builtin_amdgcn_global_load_lds((const unsigned*)(VXT + (size_t)(h_ * 256 + 64 * (qd_) + row_) * (NB * NMEM) + b_ * NMEM + 8 * lc_), (LAS unsigned*)(L + (slot_) * 32768 + (4 * w + j) * 1024), 16, 0, 0); } } while (0)
#define XA_DMA_Q(it_, qd_) do { const int tb_ = (it_) & 31, bh_ = (it_) >> 5; \
        _Pragma("unroll") for (int j = 0; j < 4; ++j) { const int row_ = 8 * j + (lane >> 3), lc_ = (lane & 7) ^ ((row_ >> 1) & 7); \
            __builtin_amdgcn_global_load_lds((const unsigned*)(QX + ((size_t)(bh_ >> 2) * SEQ + (size_t)tb_ * 256 + 32 * w + row_) * DM + (bh_ & 3) * 256 + 64 * (qd_) + 8 * lc_), (LAS unsigned*)(L + 98304 + w * 4096 + j * 1024), 16, 0, 16  ); } } while (0)
#define XA_SYNC(N) do { asm volatile("s_waitcnt vmcnt(" #N ") lgkmcnt(0)" ::: "memory"); __builtin_amdgcn_s_barrier(); asm volatile("" ::: "memory"); } while (0)
    pg8::Unit ucur; if (!S.next(0, ucur)) return;
    int it = XID(ucur);
    int s0 = 0, s1 = 1, s2 = 2;
#define XA_ROT() do { const int t_ = s0; s0 = s1; s1 = s2; s2 = t_; } while (0)
    XA_DMA_Q(it, 0); XA_DMA_K(it, 0, s0); XA_DMA_K(it, 1, s1);
    const float C = 0.0625f * LOG2E;
    const int swk = (q32 >> 1) & 7;
#pragma unroll 1
    for (int kq = 0;; ++kq) {
        const int tb = it & 31, bh = it >> 5, b = bh >> 2, h = bh & 3;
        const size_t row0 = (size_t)b * SEQ + (size_t)tb * 256 + 32 * w;
        pg8::Unit unx; const bool more = S.next(kq + 1, unx); const int itn = more ? XID(unx) : it;
        bf16x8 pf[16]; float inv;
        {
            f32x16 s[8];
#pragma unroll
            for (int mt = 0; mt < 8; ++mt)
#pragma unroll
                for (int r = 0; r < 16; ++r) s[mt][r] = 0.f;
#define XK_STEP(WAITN, QNEXT, DMA2) do { XA_SYNC(WAITN); bf16x8 q4[4]; \
                _Pragma("unroll") for (int k = 0; k < 4; ++k) q4[k] = *(const LAS bf16x8*)(L + 98304 + w * 4096 + q32 * 128 + (((2 * k + hi) ^ swk) << 4)); \
                asm volatile("s_waitcnt lgkmcnt(0)" ::: "memory"); \
                QNEXT; DMA2; \
                _Pragma("unroll") for (int k = 0; k < 4; ++k) { const int co = ((2 * k + hi) ^ swk) << 4; bf16x8 kf[8]; \
                    _Pragma("unroll") for (int mt = 0; mt < 8; ++mt) kf[mt] = *(const LAS bf16x8*)(L + s0 * 32768 + (32 * mt + q32) * 128 + co); \
                    _Pragma("unroll") for (int mt = 0; mt < 8; ++mt) s[mt] = MFMA32(kf[mt], q4[k], s[mt]); \
                      \
                    __builtin_amdgcn_sched_group_barrier(0x100, 4, 0); \
                    _Pragma("unroll") for (int i = 0; i < 4; ++i) { __builtin_amdgcn_sched_group_barrier(0x008, 1, 0); __builtin_amdgcn_sched_group_barrier(0x100, 1, 0); } \
                    __builtin_amdgcn_sched_group_barrier(0x008, 4, 0); \
                    __builtin_amdgcn_sched_barrier(0); } \
                XA_ROT(); } while (0)
            if (kq == 0) { XK_STEP(4, XA_DMA_Q(it, 1), XA_DMA_K(it, 2, s2)); } else { XK_STEP(12, XA_DMA_Q(it, 1), XA_DMA_K(it, 2, s2)); }
            XK_STEP(4, XA_DMA_Q(it, 2), XA_DMA_K(it, 3, s2));
            XK_STEP(4, XA_DMA_Q(it, 3), XA_DMA_V(it, 0, s2));
            XK_STEP(4, (void)0, XA_DMA_V(it, 1, s2));
#undef XK_STEP
            float mx = -INFINITY;
#pragma unroll
            for (int mt = 0; mt < 8; ++mt)
#pragma unroll
                for (int r = 0; r < 16; ++r) mx = fmaxf(mx, s[mt][r]);
            mx = fmaxf(mx, xor32_get(mx));
            const float mc = mx * C; float sum = 0.f;
#pragma unroll
            for (int mt = 0; mt < 8; ++mt) { float p[16];
#pragma unroll
                for (int r = 0; r < 16; ++r) { p[r] = __builtin_amdgcn_exp2f(s[mt][r] * C - mc); sum += p[r]; }
                pf[2 * mt] = pack8(p); pf[2 * mt + 1] = pack8(p + 8); }
            sum += xor32_get(sum);
            inv = 1.0f / sum;
        }
        bf16* orow0 = OX + (row0 + q32) * DM + h * 256;
#define XV_STEP(WAITN, VD, QNEXT, DMA2) do { XA_SYNC(WAITN); QNEXT; DMA2; \
            _Pragma("unroll 1") for (int dq = 0; dq < 2; ++dq) { \
                f32x16 o0; _Pragma("unroll") for (int r = 0; r < 16; ++r) o0[r] = 0.f; \
                const LAS unsigned char* vp = L + s0 * 32768 + (32 * dq + q32) * 512; \
                _Pragma("unroll") for (int kk = 0; kk < 16; ++kk) { const bf16x8 vf = *(const LAS bf16x8*)(vp + (((2 * kk + hi) ^ q32) << 4)); o0 = MFMA32(vf, pf[kk], o0); } \
                __builtin_amdgcn_sched_group_barrier(0x100, 6, 0); \
                _Pragma("unroll") for (int i = 0; i < 10; ++i) { __builtin_amdgcn_sched_group_barrier(0x008, 1, 0); __builtin_amdgcn_sched_group_barrier(0x100, 1, 0); } \
                __builtin_amdgcn_sched_group_barrier(0x008, 6, 0); \
                __builtin_amdgcn_sched_barrier(0); \
                _Pragma("unroll") for (int j = 0; j < 4; ++j) { v2u wa; wa.x = pk2(o0[4 * j] * inv, o0[4 * j + 1] * inv); wa.y = pk2(o0[4 * j + 2] * inv, o0[4 * j + 3] * inv); \
                    *(v2u*)(orow0 + 64 * (VD) + 32 * dq + 8 * j + 4 * hi) = wa; } } \
            XA_ROT(); } while (0)
        XV_STEP(4,  0, (void)0, XA_DMA_V(it, 2, s2));
        XV_STEP(12, 1, (void)0, XA_DMA_V(it, 3, s2));
        XV_STEP(12, 2, (void)0, XA_DMA_K(itn, 0, s2));
        XV_STEP(12, 3, XA_DMA_Q(itn, 0), XA_DMA_K(itn, 1, s2));
#undef XV_STEP
        if (!more) break;
        it = itn;
    }
    XA_SYNC(0);
#undef XA_DMA_K
#undef XA_DMA_V
#undef XA_DMA_Q
#undef XA_SYNC
#undef XA_ROT
#undef XID
}

__device__ __forceinline__ void final_row(float* row, const float* g, int lane) {
    f32x4* xr = (f32x4*)row + lane; const f32x4* gr = (const f32x4*)g + lane;
    f32x4 v[4]; float s = 0.f;
#pragma unroll
    for (int j = 0; j < 4; ++j) { v[j] = xr[64 * j]; s += (v[j].x * v[j].x + v[j].y * v[j].y) + (v[j].z * v[j].z + v[j].w * v[j].w); }
    const float rs = 1.f / sqrtf(wave_sum(s) * (1.f / DM) + EPS);
#pragma unroll
    for (int j = 0; j < 4; ++j) xr[64 * j] = v[j] * rs * gr[64 * j];
}

struct Args { const float* in[26]; float* out; unsigned char* ws; int ph_lo, ph_hi, flags, pad; };
constexpr int NPHASE = 10;
#ifndef DUP_P1
#define DUP_P1 1
#endif
#ifndef DUP_P4
#define DUP_P4 1
#endif
#ifndef DUP_P5
#define DUP_P5 1
#endif
#ifndef DUP_P8
#define DUP_P8 1
#endif
#ifndef DUP_ATT
#define DUP_ATT 1
#endif
#ifndef DUP_LRU
#define DUP_LRU 1
#endif
#ifndef DUP_X
#define DUP_X 1
#endif
__global__ void __launch_bounds__(512, 2) mk_fwd(Args args) {
    extern __shared__ __attribute__((aligned(16))) unsigned char lds_raw[];
    Frame F;
    F.lds = (LAS unsigned char*)lds_raw;
    F.tid = threadIdx.x; F.lane = F.tid & 63; F.wave = __builtin_amdgcn_readfirstlane(F.tid >> 6);
    F.G = gridDim.x; F.bid = blockIdx.x;
    F.out = args.out; F.ws = args.ws;
    unsigned char* ws = args.ws;
    const int lo = args.ph_lo, hi = args.ph_hi;
    volatile LAS unsigned* MISC = (volatile LAS unsigned*)(F.lds + LDS_MISC_OFF);
    if (F.tid < 64) MISC[F.tid] = 0u;
    __syncthreads();
    XcdBarrier bar = xcd_barrier_post((unsigned*)ws, MISC + 8);
#define IN(k) (lo <= (k) && (k) < hi)
#define SEAM(k) do { if (IN(k) && IN((k) + 1)) xcd_barrier(bar); } while (0)
    typedef pg8::StaticOrder SO;

    if (IN(0)) { p0_prologue(F); }
    SEAM(0);
    if (IN(1)) {
        { pg8::Gemm g{(const pg8::bf16_t*)(ws + WS_XN), (const pg8::bf16_t*)(ws + WS_WA), T, 2048, DM}; SO S; S.init(T, 2048, F.G, F.bid);
          pg8::EpiBf E{(pg8::bf16_t*)(ws + WS_PA), PAW, nullptr, 512, 0.125f * LOG2E, false, (const float*)(ws + WS_RS0), 1}; pg8::gemm_phase<pg8::EpiBf, SO, true, true>(F.lds, g, S, E); }
        { pg8::Gemm g{(const pg8::bf16_t*)(ws + WS_WV), (const pg8::bf16_t*)(ws + WS_XN), 512, T, DM}; SO S; S.init(512, T, F.G, F.bid);
          pg8::EpiBf E{(pg8::bf16_t*)(ws + WS_VT), T, nullptr, 0, 1.0f, true, (const float*)(ws + WS_RS0), 2}; pg8::gemm_phase<pg8::EpiBf, SO, true, true>(F.lds, g, S, E); }
    }
    SEAM(1);
    if (IN(2)) {
        if (!(args.flags & 16)) for (int rep = 0; rep < DUP_ATT; ++rep) attn_phase(F);
        __syncthreads();
        if (!(args.flags & 8)) for (int rep = 0; rep < DUP_LRU; ++rep) for (int it = F.bid; it < NB * NCH; it += F.G) lru1_item(F, it / NCH, it % NCH);
        __syncthreads();
    }
    SEAM(2);
    if (IN(3)) { for (int it = F.bid; it < NB * NCH; it += F.G) lru3_item(F, it / NCH, it % NCH); }
    SEAM(3);
    if (IN(4)) { pg8::Gemm g{(const pg8::bf16_t*)(ws + WS_MERGED), (const pg8::bf16_t*)(ws + WS_WOUT), T, DM, DM}; SO S; S.init(T, DM, F.G, F.bid);
        pg8::EpiRes<false> E{nullptr, (const pg8::bf16_t*)(ws + WS_XN), (pg8::bf16_t*)(ws + WS_XB), (float*)(ws + WS_SS1)}; pg8::gemm_phase<pg8::EpiRes<false>, SO, true, true>(F.lds, g, S, E); }
    SEAM(4);
    if (IN(5)) { pg8::Gemm g{(const pg8::bf16_t*)(ws + WS_XB), (const pg8::bf16_t*)(ws + WS_WQ), T, DM, DM}; SO S; S.init(T, DM, F.G, F.bid);
        pg8::EpiBf E{(pg8::bf16_t*)(ws + WS_QX), DM, (const float*)(ws + WS_SS1), 0, 1.0f, false}; pg8::gemm_phase<pg8::EpiBf, SO, true, true>(F.lds, g, S, E);
        asm volatile("s_waitcnt vmcnt(0)" ::: "memory"); __syncthreads();
        if (!(args.flags & 1)) xattn_phase(F, S); }
    SEAM(6);
    if (IN(7)) { pg8::Gemm g{(const pg8::bf16_t*)(ws + WS_OX), (const pg8::bf16_t*)(ws + WS_WO), T, DM, DM}; SO S; S.init(T, DM, F.G, F.bid);
        pg8::EpiRes<false> E{nullptr, (const pg8::bf16_t*)(ws + WS_XB), (pg8::bf16_t*)(ws + WS_XB2), (float*)(ws + WS_SS2)}; pg8::gemm_phase<pg8::EpiRes<false>, SO, true, true>(F.lds, g, S, E); }
    SEAM(7);
    if (IN(8)) { pg8::Gemm g{(const pg8::bf16_t*)(ws + WS_XB2), (const pg8::bf16_t*)(ws + WS_WGU), T, 2 * DFF, DM}; SO S; S.init(T, 2 * DFF, F.G, F.bid);
        pg8::EpiSwiGLU E{(pg8::bf16_t*)(ws + WS_ACT), DFF, (const float*)(ws + WS_SS2)}; pg8::gemm_phase<pg8::EpiSwiGLU, SO, true, true>(F.lds, g, S, E); }
    SEAM(8);
    if (IN(9)) { pg8::Gemm g{(const pg8::bf16_t*)(ws + WS_ACT), (const pg8::bf16_t*)(ws + WS_WDN), T, DM, DFF}; SO S; S.init(T, DM, F.G, F.bid);
        pg8::EpiFinal E{(const pg8::bf16_t*)(ws + WS_XB2), F.out, inp(I_GFINAL), (float*)(ws + WS_SS1), (unsigned*)(ws + 16384), args.flags}; pg8::gemm_phase<pg8::EpiFinal, SO, true, true>(F.lds, g, S, E); }
#undef IN
#undef SEAM
}

#ifndef MK_N_LAUNCHES
#define MK_N_LAUNCHES 1
#endif
extern "C" void kernel_launch(void* const* d_in, const int* in_sizes, int n_in, void* d_out, int out_size, void* d_ws, size_t ws_size, hipStream_t stream) {
    static int grid = 0;
    if (grid == 0) {
        if (n_in != 26 || in_sizes[0] != T * DM || out_size != T * DM || ws_size < WS_END) { fprintf(stderr, "kernel_launch: unexpected shapes (n_in %d, ws %zu); nothing launched\n", n_in, ws_size); grid = -1; return; }
        int dev = 0, cus = 0, per_cu = 0;
        if (hipGetDevice(&dev) != hipSuccess || hipDeviceGetAttribute(&cus, hipDeviceAttributeMultiprocessorCount, dev) != hipSuccess) { grid = -1; return; }
        if (hipFuncSetAttribute((const void*)mk_fwd, hipFuncAttributeMaxDynamicSharedMemorySize, LDS_BYTES) != hipSuccess) { fprintf(stderr, "kernel_launch: hipFuncSetAttribute failed\n"); grid = -1; return; }
        if (hipOccupancyMaxActiveBlocksPerMultiprocessor(&per_cu, (const void*)mk_fwd, 512, LDS_BYTES) != hipSuccess || per_cu < 1) { fprintf(stderr, "kernel_launch: occupancy query says %d\n", per_cu); per_cu = 1; }
        (void)hipGetLastError();
        grid = cus;
    }
    if (grid < 0) return;
    Args a{};
    for (int i = 0; i < 26; ++i) a.in[i] = (const float*)d_in[i];
    a.out = (float*)d_out; a.ws = (unsigned char*)d_ws;
    if (MK_N_LAUNCHES == 1) {
        a.ph_lo = 0; a.ph_hi = NPHASE;
        if (hipMemsetAsync(d_ws, 0, 65536, stream) != hipSuccess) { fprintf(stderr, "kernel_launch: memset failed\n"); return; }
        hipLaunchKernelGGL(mk_fwd, dim3(grid), dim3(512), LDS_BYTES, stream, a);
    } else {
        if (hipMemsetAsync(d_ws, 0, 65536, stream) != hipSuccess) return;
        for (int p = 0; p < NPHASE; ++p) { if (p == 6) continue;
            a.ph_lo = p; a.ph_hi = p + 1; hipLaunchKernelGGL(mk_fwd, dim3(grid), dim3(512), LDS_BYTES, stream, a);
#ifdef MK_PROBE_PHASE
            if (p == MK_PROBE_PHASE) {
#ifdef MK_PROBE_FLAGS
                a.flags = MK_PROBE_FLAGS;
#endif
                hipLaunchKernelGGL(mk_fwd, dim3(grid), dim3(512), LDS_BYTES, stream, a); a.flags = 0; }
#endif
        }
    }
}
```
